# Optimizing an MI355X kernel written in HIP

```python
import jax, jax.numpy as jnp
from jax import lax
import numpy as np

D_MODEL = 1024
BATCH = 2
SEQ = 8192
DEPTH = 2

N_MIXERS = 2
N_A = (DEPTH + 1) // 2
N_B = DEPTH // 2
D_FF = 2816
LRU_WIDTH = D_MODEL
LRU_HEADS = 16
LRU_HEAD_DIM = LRU_WIDTH // LRU_HEADS
LRU_C = 8.0
CONV_WIDTH = 4
SG_WIDTH = D_MODEL
SG_HEADS = 8
SG_HEAD_DIM = SG_WIDTH // SG_HEADS
CHUNK = 128
NORM_EPS = 1e-6

kernel_name = "hybrid_rglru_chunked_gmlp_macaron"


def rms_norm(x, g):
    xf = x.astype(jnp.float32)
    y = xf * lax.rsqrt(jnp.mean(xf * xf, axis=-1, keepdims=True) + NORM_EPS)
    return (y * g.astype(jnp.float32)).astype(x.dtype)


def swiglu(x, w_in, w_out):
    g, u = jnp.split(x @ w_in, 2, axis=-1)
    return (jax.nn.silu(g) * u) @ w_out


def causal_depthwise_conv(x, w, b):
    k_width = w.shape[0]
    s = x.shape[1]
    xp = jnp.pad(x, ((0, 0), (k_width - 1, 0), (0, 0)))
    out = b + xp[:, 0:s] * w[0]
    for k in range(1, k_width):
        out = out + xp[:, k:k + s] * w[k]
    return out


def block_diag_linear(x, w, b):
    bsz, s, _ = x.shape
    h, dh, _ = w.shape
    xh = x.reshape(bsz, s, h, dh)
    return (jnp.einsum('bshi,hij->bshj', xh, w) + b).reshape(bsz, s, h * dh)


def rg_lru(x, w_a, b_a, w_x, b_x, lam):
    f32 = jnp.float32
    xf = x.astype(f32)
    gate_a = jax.nn.sigmoid(block_diag_linear(xf, w_a.astype(f32), b_a.astype(f32)))
    gate_x = jax.nn.sigmoid(block_diag_linear(xf, w_x.astype(f32), b_x.astype(f32)))
    log_a = -LRU_C * gate_a * jax.nn.softplus(-lam.astype(f32))
    a = jnp.exp(log_a)
    mult = jnp.sqrt(-jnp.expm1(2.0 * log_a))
    bx = xf * gate_x * mult

    def combine(left, right):
        a_l, b_l = left
        a_r, b_r = right
        return a_l * a_r, a_r * b_l + b_r

    _, h = lax.associative_scan(combine, (a, bx), axis=1)
    return h.astype(x.dtype)


def recurrent_mixer(x, w_in, conv_w, conv_b, gate_a_w, gate_a_b, gate_x_w, gate_x_b, lam, w_out):
    y, r = jnp.split(x @ w_in, 2, axis=-1)
    y = jax.nn.gelu(y)
    r = causal_depthwise_conv(r, conv_w, conv_b)
    h = rg_lru(r, gate_a_w, gate_a_b, gate_x_w, gate_x_b, lam)
    return (y * h) @ w_out


def spatial_gating_mixer(x, w_in, v_norm, w_s, b_s, w_out):
    bsz, s, _ = x.shape
    u, v = jnp.split(jax.nn.gelu(x @ w_in), 2, axis=-1)
    v = rms_norm(v, v_norm)
    h, p, _ = w_s.shape
    c = v.shape[-1] // h
    vc = v.reshape(bsz, s // p, p, h, c)
    causal = jnp.tril(jnp.ones((p, p), dtype=bool))
    ws = jnp.where(causal[None], w_s, jnp.zeros_like(w_s))
    sg = jnp.einsum('hpq,bnqhc->bnphc', ws, vc) + b_s.T[:, :, None]
    sg = sg.reshape(bsz, s, h * c)
    return (u * sg) @ w_out


def setup_inputs(seed: int = 0) -> dict:
    key = jax.random.key(seed)
    ks = jax.random.split(key, 32)
    f32 = jnp.float32

    def nrm(k, shape, fan_in):
        return jax.random.normal(k, shape, f32) * (fan_in ** -0.5)

    def gain(k, shape):
        return 1.0 + 0.05 * jax.random.normal(k, shape, f32)

    def small(k, shape):
        return 0.01 * jax.random.normal(k, shape, f32)

    x = jax.random.normal(ks[0], (BATCH, SEQ, D_MODEL), f32)

    a0 = jax.random.uniform(ks[14], (N_A, LRU_WIDTH), f32, 0.9, 0.999)
    p0 = a0 ** (1.0 / LRU_C)
    rec_lambda = jnp.log(p0) - jnp.log1p(-p0)

    return {
        "x": x,
        "ffn1_norm": gain(ks[1], (DEPTH, D_MODEL)),
        "ffn1_w_in": nrm(ks[2], (DEPTH, D_MODEL, 2 * D_FF), D_MODEL),
        "ffn1_w_out": nrm(ks[3], (DEPTH, D_FF, D_MODEL), D_FF),
        "mix_norm": gain(ks[4], (DEPTH, D_MODEL)),
        "ffn2_norm": gain(ks[5], (DEPTH, D_MODEL)),
        "ffn2_w_in": nrm(ks[6], (DEPTH, D_MODEL, 2 * D_FF), D_MODEL),
        "ffn2_w_out": nrm(ks[7], (DEPTH, D_FF, D_MODEL), D_FF),
        "rec_w_in": nrm(ks[8], (N_A, D_MODEL, 2 * LRU_WIDTH), D_MODEL),
        "rec_conv_w": nrm(ks[9], (N_A, CONV_WIDTH, LRU_WIDTH), CONV_WIDTH),
        "rec_conv_b": small(ks[10], (N_A, LRU_WIDTH)),
        "rec_gate_a_w": nrm(ks[11], (N_A, LRU_HEADS, LRU_HEAD_DIM, LRU_HEAD_DIM), LRU_HEAD_DIM),
        "rec_gate_a_b": small(ks[12], (N_A, LRU_HEADS, LRU_HEAD_DIM)),
        "rec_gate_x_w": nrm(ks[13], (N_A, LRU_HEADS, LRU_HEAD_DIM, LRU_HEAD_DIM), LRU_HEAD_DIM),
        "rec_gate_x_b": small(ks[15], (N_A, LRU_HEADS, LRU_HEAD_DIM)),
        "rec_lambda": rec_lambda,
        "rec_w_out": nrm(ks[16], (N_A, LRU_WIDTH, D_MODEL), LRU_WIDTH),
        "sg_w_in": nrm(ks[17], (N_B, D_MODEL, 2 * SG_WIDTH), D_MODEL),
        "sg_v_norm": gain(ks[18], (N_B, SG_WIDTH)),
        "sg_w_s": nrm(ks[19], (N_B, SG_HEADS, CHUNK, CHUNK), CHUNK),
        "sg_b_s": 1.0 + 0.1 * jax.random.normal(ks[20], (N_B, SG_HEADS, CHUNK), f32),
        "sg_w_out": nrm(ks[21], (N_B, SG_WIDTH, D_MODEL), SG_WIDTH),
        "final_norm": gain(ks[22], (D_MODEL,)),
    }


def reference(x, ffn1_norm, ffn1_w_in, ffn1_w_out, mix_norm, ffn2_norm, ffn2_w_in, ffn2_w_out,
              rec_w_in, rec_conv_w, rec_conv_b, rec_gate_a_w, rec_gate_a_b, rec_gate_x_w, rec_gate_x_b,
              rec_lambda, rec_w_out, sg_w_in, sg_v_norm, sg_w_s, sg_b_s, sg_w_out, final_norm):
    h = x
    for i in range(DEPTH):
        h = h + 0.5 * swiglu(rms_norm(h, ffn1_norm[i]), ffn1_w_in[i], ffn1_w_out[i])
        hn = rms_norm(h, mix_norm[i])
        j = i // N_MIXERS
        if i % N_MIXERS == 0:
            m = recurrent_mixer(hn, rec_w_in[j], rec_conv_w[j], rec_conv_b[j], rec_gate_a_w[j], rec_gate_a_b[j],
                                rec_gate_x_w[j], rec_gate_x_b[j], rec_lambda[j], rec_w_out[j])
        else:
            m = spatial_gating_mixer(hn, sg_w_in[j], sg_v_norm[j], sg_w_s[j], sg_b_s[j], sg_w_out[j])
        h = h + m
        h = h + 0.5 * swiglu(rms_norm(h, ffn2_norm[i]), ffn2_w_in[i], ffn2_w_out[i])
    return rms_norm(h, final_norm)
```

```cpp
#include <hip/hip_runtime.h>
#include <cstdio>
#include <cstdint>
#include <cmath>
namespace pg8 {
#define PG8_LAS __attribute__((address_space(3)))
typedef unsigned short bf16_t;
typedef short bf16x8 __attribute__((ext_vector_type(8)));
typedef float f32x4 __attribute__((ext_vector_type(4)));
typedef unsigned u32x4 __attribute__((ext_vector_type(4)));
constexpr int BM = 256, BK = 64, HALF = 128, HTB = HALF * BK * 2  , STAGE_BYTES = 8 * HTB, NXCD = 8, WGM = 8;

__host__ __device__ __forceinline__ int lds_byte(int r, int c) { const int st = (r >> 4) * 2 + (c >> 5), rr = r & 15, cc = c & 31, ob = rr * 64 + cc * 2; return st * 1024 + (ob ^ (((ob >> 9) & 1) << 5)); }
__host__ __device__ __forceinline__ void stage_rc(int b, int& R, int& C) { const int st = b / 1024, sb = b % 1024, swz = sb ^ (((sb >> 9) & 1) << 5); R = (st >> 1) * 16 + swz / 64; C = (st & 1) * 32 + (swz % 64) / 2; }
__host__ __device__ __forceinline__ int perm32(int rho) { const int n = rho >> 4, i = rho & 15; return 8 * (i >> 2) + 4 * n + (i & 3); }

struct Unit { int pm, pn; };
struct Gemm { const bf16_t* A; const bf16_t* Bt; int M, N, K; };

struct StaticOrder {
    int nM, nN, nwg, G, c;
    __host__ __device__ void init(int M, int N, int G_, int c_) { nM = M / BM; nN = N / BM; nwg = nM * nN; G = G_; c = c_; }
    __host__ __device__ bool next(int i, Unit& u) const {
        const long L = (long)i * G + c; if (L >= nwg) return false;
        int wgid = (int)L; { const int q = nwg / NXCD, r = nwg % NXCD, xcd = wgid % NXCD, off = wgid / NXCD; wgid = (xcd < r ? xcd * (q + 1) : r * (q + 1) + (xcd - r) * q) + off; }
        const int nig = WGM * nN, gid = wgid / nig, fm = gid * WGM, gsz = (nM - fm) < WGM ? (nM - fm) : WGM;
        u.pm = fm + ((wgid % nig) % gsz); u.pn = (wgid % nig) / gsz; return true;
    }
    __device__ __forceinline__ void a_ready(const Unit&) const {}
    __device__ __forceinline__ void done(const Unit&) const {}
};

__device__ __forceinline__ unsigned cvt_pk_bf16(float lo, float hi) { unsigned r; asm volatile("v_cvt_pk_bf16_f32 %0, %1, %2" : "=v"(r) : "v"(lo), "v"(hi)); return r; }
typedef float f32x2 __attribute__((ext_vector_type(2)));
__device__ __forceinline__ float sigmoid_f(float x) { return __builtin_amdgcn_rcpf(1.0f + __builtin_amdgcn_exp2f(-1.4426950408889634f * x)); }
__device__ __forceinline__ float silu_f(float x) { return x * sigmoid_f(x); }
__device__ __forceinline__ float gelu_f(float x) {
    const float u = x * (1.0f + 0.044715f * x * x);
    return x * __builtin_amdgcn_rcpf(1.0f + __builtin_amdgcn_exp2f(-2.302208198f * u));
}
__device__ __forceinline__ void load_rinv(float (&ri)[2][4], const float* ssp, int pm, int wr, int fr, int fq, float eps) {
#pragma unroll
    for (int ai = 0; ai < 2; ++ai)
#pragma unroll
        for (int m = 0; m < 4; ++m) {
            const f32x4 v = *(const f32x4*)(ssp + (size_t)(pm * BM + ai * HALF + wr * 64 + m * 16 + fr) * 16 + 4 * fq);
            float s = (v[0] + v[1]) + (v[2] + v[3]);
            s += __shfl_xor(s, 16); s += __shfl_xor(s, 32);
            ri[ai][m] = __builtin_amdgcn_rsqf(s * (1.0f / 1024.0f) + eps);
        }
}
struct EpiSwiGLU {
    static constexpr bool PERM = true, AFTER_DRAIN = false;
    bf16_t* H; int ldh; const float* ssp; float eps;
    __device__ __forceinline__ void operator()(const f32x4 (&acc)[2][2][4][2], const Unit& u, int wr, int wc, int fr, int fq) const {
        float ri[2][4]; load_rinv(ri, ssp, u.pm, wr, fr, fq, eps);
        const int col0 = u.pn * HALF + wc * 32 + 8 * fq;
#pragma unroll
        for (int ai = 0; ai < 2; ++ai)
#pragma unroll
            for (int m = 0; m < 4; ++m) {
                const int row = u.pm * BM + ai * HALF + wr * 64 + m * 16 + fr; const float r = ri[ai][m];
                const f32x4 g0 = acc[ai][0][m][0] * r, g1 = acc[ai][0][m][1] * r, u0 = acc[ai][1][m][0] * r, u1 = acc[ai][1][m][1] * r;
                u32x4 w;
                w.x = cvt_pk_bf16(silu_f(g0[0]) * u0[0], silu_f(g0[1]) * u0[1]); w.y = cvt_pk_bf16(silu_f(g0[2]) * u0[2], silu_f(g0[3]) * u0[3]);
                w.z = cvt_pk_bf16(silu_f(g1[0]) * u1[0], silu_f(g1[1]) * u1[1]); w.w = cvt_pk_bf16(silu_f(g1[2]) * u1[2], silu_f(g1[3]) * u1[3]);
                *(u32x4*)(H + (size_t)row * ldh + col0) = w;
            }
    }
};
struct EpiRes {
    static constexpr bool PERM = true, AFTER_DRAIN = false;
    const float* base; float* out; bf16_t* xa; float* ssp_out; float alpha;
    __device__ __forceinline__ void operator()(const f32x4 (&acc)[2][2][4][2], const Unit& u, int wr, int wc, int fr, int fq) const {
        const int col0 = u.pn * BM + wc * 32 + 8 * fq;
#pragma unroll
        for (int ai = 0; ai < 2; ++ai)
#pragma unroll
            for (int m = 0; m < 4; ++m) {
                const int row = u.pm * BM + ai * HALF + wr * 64 + m * 16 + fr; float ss = 0.f;
#pragma unroll
                for (int bj = 0; bj < 2; ++bj) {
                    const size_t off = (size_t)row * 1024 + col0 + bj * HALF;
                    const f32x4 b0 = *(const f32x4*)(base + off), b1 = *(const f32x4*)(base + off + 4);
                    const f32x4 v0 = b0 + acc[ai][bj][m][0] * alpha, v1 = b1 + acc[ai][bj][m][1] * alpha;
                    *(f32x4*)(out + off) = v0; *(f32x4*)(out + off + 4) = v1;
                    u32x4 w; w.x = cvt_pk_bf16(v0[0], v0[1]); w.y = cvt_pk_bf16(v0[2], v0[3]); w.z = cvt_pk_bf16(v1[0], v1[1]); w.w = cvt_pk_bf16(v1[2], v1[3]);
                    *(u32x4*)(xa + off) = w;
                    ss += (v0[0] * v0[0] + v0[1] * v0[1]) + (v0[2] * v0[2] + v0[3] * v0[3]) + (v1[0] * v1[0] + v1[1] * v1[1]) + (v1[2] * v1[2] + v1[3] * v1[3]);
                }
                ss += __shfl_xor(ss, 16); ss += __shfl_xor(ss, 32);
                if (fq == 0) ssp_out[(size_t)row * 16 + u.pn * 4 + wc] = ss;
            }
    }
};
struct EpiMixIn {
    static constexpr bool PERM = true, AFTER_DRAIN = false;
    bf16_t* O; const float* ssp; float eps; int mode; float* vssp;
    __device__ __forceinline__ void operator()(const f32x4 (&acc)[2][2][4][2], const Unit& u, int wr, int wc, int fr, int fq) const {
        float ri[2][4]; load_rinv(ri, ssp, u.pm, wr, fr, fq, eps);
        const int col0 = u.pn * BM + wc * 32 + 8 * fq;
        const bool act = (mode == 1) || (u.pn < 4), vs = (mode == 1) && (u.pn >= 4);
#pragma unroll
        for (int ai = 0; ai < 2; ++ai)
#pragma unroll
            for (int m = 0; m < 4; ++m) {
                const int row = u.pm * BM + ai * HALF + wr * 64 + m * 16 + fr; const float r = ri[ai][m]; float ss = 0.f;
#pragma unroll
                for (int bj = 0; bj < 2; ++bj) {
                    f32x4 v0 = acc[ai][bj][m][0] * r, v1 = acc[ai][bj][m][1] * r;
                    if (act) {
#pragma unroll
                        for (int j = 0; j < 4; ++j) { v0[j] = gelu_f(v0[j]); v1[j] = gelu_f(v1[j]); }
                    }
                    ss += (v0[0] * v0[0] + v0[1] * v0[1]) + (v0[2] * v0[2] + v0[3] * v0[3]) + (v1[0] * v1[0] + v1[1] * v1[1]) + (v1[2] * v1[2] + v1[3] * v1[3]);
                    u32x4 w; w.x = cvt_pk_bf16(v0[0], v0[1]); w.y = cvt_pk_bf16(v0[2], v0[3]); w.z = cvt_pk_bf16(v1[0], v1[1]); w.w = cvt_pk_bf16(v1[2], v1[3]);
                    *(u32x4*)(O + (size_t)row * 2048 + col0 + bj * HALF) = w;
                }
                if (vs) { ss += __shfl_xor(ss, 16); ss += __shfl_xor(ss, 32); if (fq == 0) vssp[(size_t)row * 16 + (u.pn - 4) * 4 + wc] = ss; }
            }
    }
};

template <class Epi, class Sched, bool ALIGN_EPI = false, bool SP2 = false>
__device__ __forceinline__ void gemm_phase(PG8_LAS unsigned char* lds, const Gemm g, const Sched& S, const Epi& E) {
    const int tid = threadIdx.x, wid = __builtin_amdgcn_readfirstlane(tid >> 6), lane = tid & 63, wr = wid >> 2, wc = wid & 3, fr = lane & 15, fq = lane >> 4;
    const int K = g.K, nt = K / BK;
    unsigned voffA[2], voffB[2];
#pragma unroll
    for (int i = 0; i < 2; ++i) { int R, C; stage_rc(tid * 16 + i * 8192, R, C); const int Rb = Epi::PERM ? ((R & ~31) + perm32(R & 31)) : R;
        voffA[i] = (unsigned)(R * K + C) * 2u; voffB[i] = (unsigned)(Rb * K + C) * 2u; }
    const size_t kstep = (size_t)(BK * 2);
    const size_t hstep = (size_t)HALF * K * 2;
    const size_t tstep = 2 * hstep;
    const unsigned ldsw = (unsigned)wid * 1024u;
    const int aoff = lds_byte(wr * 64 + fr, fq * 8), boff = lds_byte(wc * 32 + fr, fq * 8);
#define PG8_SA(b, h) (((b) * 2 + (h)) * HTB)
#define PG8_SB(b, h) ((4 + (b) * 2 + (h)) * HTB)
#define PG8_STAGE(bufoff, gbase, voff) do { _Pragma("unroll") for (int _i = 0; _i < 2; ++_i) \
        __builtin_amdgcn_global_load_lds((const unsigned*)((const char*)(gbase) + (voff)[_i]), (PG8_LAS unsigned*)(lds + (bufoff) + ldsw + _i * 8192), 16, 0, 0); } while (0)
#define PG8_LDA(dst, b, h) do { _Pragma("unroll") for (int m = 0; m < 4; ++m) _Pragma("unroll") for (int k = 0; k < 2; ++k) dst[m][k] = *(const PG8_LAS bf16x8*)(lds + PG8_SA(b, h) + aoff + m * 2048 + k * 1024); } while (0)
#define PG8_LDB(dst, b, h) do { _Pragma("unroll") for (int n = 0; n < 2; ++n) _Pragma("unroll") for (int k = 0; k < 2; ++k) dst[n][k] = *(const PG8_LAS bf16x8*)(lds + PG8_SB(b, h) + boff + n * 2048 + k * 1024); } while (0)
#define PG8_MMA(ai, bj, At, Bt) do { __builtin_amdgcn_s_setprio(1); _Pragma("unroll") for (int m = 0; m < 4; ++m) _Pragma("unroll") for (int n = 0; n < 2; ++n) _Pragma("unroll") for (int k = 0; k < 2; ++k) \
        acc[ai][bj][m][n] = __builtin_amdgcn_mfma_f32_16x16x32_bf16(Bt[n][k], At[m][k], acc[ai][bj][m][n], 0, 0, 0); __builtin_amdgcn_s_setprio(0); } while (0)
#define PG8_WAIT_V(n) asm volatile("s_waitcnt vmcnt(" #n ")" ::: "memory")
#define PG8_WAIT_L(n) asm volatile("s_waitcnt lgkmcnt(" #n ")" ::: "memory")
#define PG8_BAR __builtin_amdgcn_s_barrier()
#define PG8_SCHED __builtin_amdgcn_sched_barrier(0)
    Unit cur, nxt; int ui = 0;
    if (!S.next(0, cur)) return;
    f32x4 acc[2][2][4][2];
#pragma unroll
    for (int a = 0; a < 2; ++a)
#pragma unroll
        for (int b = 0; b < 2; ++b)
#pragma unroll
            for (int m = 0; m < 4; ++m)
#pragma unroll
                for (int n = 0; n < 2; ++n) acc[a][b][m][n] = (f32x4){0.f, 0.f, 0.f, 0.f};
    bf16x8 At[4][2], B0[2][2], B1[2][2];
    const char* cA = (const char*)g.A + (size_t)cur.pm * tstep; const char* cB = (const char*)g.Bt + (size_t)cur.pn * tstep;
    S.a_ready(cur);
    if constexpr (SP2) {
        PG8_STAGE(PG8_SB(0, 0), cB, voffB); PG8_STAGE(PG8_SB(0, 1), cB + hstep, voffB); PG8_STAGE(PG8_SA(0, 0), cA, voffA); PG8_STAGE(PG8_SA(0, 1), cA + hstep, voffA);
        if (wr == 1) PG8_BAR;
        PG8_WAIT_V(2); PG8_BAR;
        PG8_STAGE(PG8_SB(1, 0), cB + kstep, voffB); PG8_STAGE(PG8_SA(1, 0), cA + kstep, voffA); PG8_STAGE(PG8_SB(1, 1), cB + hstep + kstep, voffB);
        PG8_WAIT_V(6); PG8_BAR;
    } else {
        PG8_STAGE(PG8_SB(0, 0), cB, voffB); PG8_STAGE(PG8_SA(0, 0), cA, voffA); PG8_STAGE(PG8_SB(0, 1), cB + hstep, voffB); PG8_STAGE(PG8_SA(0, 1), cA + hstep, voffA);
        if (wr == 1) PG8_BAR;
        PG8_WAIT_V(4); PG8_BAR;
        PG8_STAGE(PG8_SB(1, 0), cB + kstep, voffB); PG8_STAGE(PG8_SA(1, 0), cA + kstep, voffA); PG8_STAGE(PG8_SB(1, 1), cB + hstep + kstep, voffB);
        PG8_WAIT_V(6); PG8_BAR;
    }
    for (;;) {
        const bool has_next = S.next(ui + 1, nxt);
        const char* nA = has_next ? (const char*)g.A + (size_t)nxt.pm * tstep : cA; const char* nB = has_next ? (const char*)g.Bt + (size_t)nxt.pn * tstep : cB;
        for (int t = 0; t < nt; t += 2) {
            const bool last = (t == nt - 2);
            const char* a1 = cA + (size_t)(t + 1) * kstep;
            const char* a2 = last ? nA : cA + (size_t)(t + 2) * kstep; const char* b2 = last ? nB : cB + (size_t)(t + 2) * kstep;
            const char* a3 = a2 + kstep; const char* b3 = b2 + kstep;
            if (last && has_next) S.a_ready(nxt);
            if constexpr (SP2) {
            PG8_LDB(B0, 0, 0); PG8_LDB(B1, 0, 1); PG8_SCHED; PG8_LDA(At, 0, 0); PG8_STAGE(PG8_SA(1, 1), a1 + hstep, voffA);
            PG8_WAIT_V(8); PG8_WAIT_L(0); PG8_BAR; PG8_MMA(0, 0, At, B0); PG8_MMA(0, 1, At, B1); PG8_BAR; PG8_SCHED;
            PG8_LDA(At, 0, 1); PG8_STAGE(PG8_SB(0, 0), b2, voffB); PG8_STAGE(PG8_SB(0, 1), b2 + hstep, voffB); PG8_STAGE(PG8_SA(0, 0), a2, voffA);
            PG8_WAIT_V(8); PG8_WAIT_L(0); PG8_BAR; PG8_MMA(1, 0, At, B0); PG8_MMA(1, 1, At, B1); PG8_BAR; PG8_SCHED;
            PG8_LDB(B0, 1, 0); PG8_LDB(B1, 1, 1); PG8_SCHED; PG8_LDA(At, 1, 0); PG8_STAGE(PG8_SA(0, 1), a2 + hstep, voffA);
            PG8_WAIT_V(8); PG8_WAIT_L(0); PG8_BAR; PG8_MMA(0, 0, At, B0); PG8_MMA(0, 1, At, B1); PG8_BAR; PG8_SCHED;
            PG8_LDA(At, 1, 1); PG8_STAGE(PG8_SB(1, 0), b3, voffB); PG8_STAGE(PG8_SB(1, 1), b3 + hstep, voffB); PG8_STAGE(PG8_SA(1, 0), a3, voffA);
            PG8_WAIT_V(8); PG8_WAIT_L(0); PG8_BAR; PG8_MMA(1, 0, At, B0); PG8_MMA(1, 1, At, B1); PG8_BAR; PG8_SCHED;
            } else {
            PG8_LDB(B0, 0, 0); PG8_SCHED; PG8_LDA(At, 0, 0); PG8_STAGE(PG8_SA(1, 1), a1 + hstep, voffA);
            PG8_WAIT_L(8); PG8_BAR; PG8_WAIT_L(0); PG8_MMA(0, 0, At, B0); PG8_BAR; PG8_SCHED;
            PG8_LDB(B1, 0, 1); PG8_STAGE(PG8_SB(0, 0), b2, voffB);
            PG8_BAR; PG8_WAIT_L(0); PG8_MMA(0, 1, At, B1); PG8_BAR;
            PG8_LDA(At, 0, 1); PG8_STAGE(PG8_SA(0, 0), a2, voffA);
            PG8_BAR; PG8_WAIT_L(0); PG8_MMA(1, 0, At, B0); PG8_BAR; PG8_SCHED;
            PG8_STAGE(PG8_SB(0, 1), b2 + hstep, voffB);
            PG8_WAIT_V(6); PG8_BAR; PG8_MMA(1, 1, At, B1); PG8_BAR;
            PG8_LDB(B0, 1, 0); PG8_SCHED; PG8_LDA(At, 1, 0); PG8_STAGE(PG8_SA(0, 1), a2 + hstep, voffA);
            PG8_WAIT_L(8); PG8_BAR; PG8_WAIT_L(0); PG8_MMA(0, 0, At, B0); PG8_BAR; PG8_SCHED;
            PG8_LDB(B1, 1, 1); PG8_STAGE(PG8_SB(1, 0), b3, voffB);
            PG8_BAR; PG8_WAIT_L(0); PG8_MMA(0, 1, At, B1); PG8_BAR;
            PG8_LDA(At, 1, 1); PG8_STAGE(PG8_SA(1, 0), a3, voffA);
            PG8_BAR; PG8_WAIT_L(0); PG8_MMA(1, 0, At, B0); PG8_BAR; PG8_SCHED;
            PG8_STAGE(PG8_SB(1, 1), b3 + hstep, voffB);
            PG8_WAIT_V(6); PG8_BAR; PG8_MMA(1, 1, At, B1); PG8_BAR;
            }
        }
        if constexpr (ALIGN_EPI) { if (wr == 0) PG8_BAR; }
        if constexpr (!Epi::AFTER_DRAIN) { E(acc, cur, wr, wc, fr, fq); S.done(cur); }
        if (!has_next) break;
#pragma unroll
        for (int a = 0; a < 2; ++a)
#pragma unroll
            for (int b = 0; b < 2; ++b)
#pragma unroll
                for (int m = 0; m < 4; ++m)
#pragma unroll
                    for (int n = 0; n < 2; ++n) acc[a][b][m][n] = (f32x4){0.f, 0.f, 0.f, 0.f};
        cur = nxt; cA = nA; cB = nB; ++ui;
        if constexpr (ALIGN_EPI) { if (wr == 1) PG8_BAR; }
    }
    PG8_WAIT_V(0);
    if constexpr (!ALIGN_EPI) { if (wr == 0) PG8_BAR; }
    PG8_BAR;
    if constexpr (Epi::AFTER_DRAIN) { E.fused(acc, cur, wr, wc, fr, fq, lds, wid, lane); S.done(cur); }
#undef PG8_SA
#undef PG8_SB
#undef PG8_STAGE
#undef PG8_LDA
#undef PG8_LDB
#undef PG8_MMA
#undef PG8_WAIT_V
#undef PG8_WAIT_L
#undef PG8_BAR
#undef PG8_SCHED
}
}
#define GAS __attribute__((address_space(1)))
#define LAS __attribute__((address_space(3)))
typedef unsigned short bf16;
typedef unsigned v4u __attribute__((ext_vector_type(4)));
typedef float f32x4 __attribute__((ext_vector_type(4)));
typedef short bf16x8 __attribute__((ext_vector_type(8)));
typedef GAS unsigned gu32;
typedef GAS unsigned long long gu64;
#define RLX_AGENT __ATOMIC_RELAXED, __HIP_MEMORY_SCOPE_AGENT
#define LDS_WAIT() asm volatile("s_waitcnt lgkmcnt(0)" ::: "memory")
#define VM_WAIT() asm volatile("s_waitcnt vmcnt(0)" ::: "memory")
__device__ __forceinline__ unsigned long long rt() { return __builtin_amdgcn_s_memrealtime(); }
__device__ __forceinline__ unsigned f2bf(float f) { unsigned u = __builtin_bit_cast(unsigned, f); return (u + 0x7fffu + ((u >> 16) & 1u)) >> 16; }
__device__ __forceinline__ unsigned pk2(float lo, float hi) { return f2bf(lo) | (f2bf(hi) << 16); }

#define XB_TMO      128
#define XB_XCNT(j)  (256  + 64 * (j))
#define XB_XSUB(j)  (1280 + 64 * (j))
#define XB_XGEN(j)  (2304 + 64 * (j))
#define XB_TOP      3328
#define XB_TOPGEN   3392
#define XCD_BAR_WORDS 3456
#define XB_SPIN_CAP (1u << 18)

__device__ __forceinline__ unsigned xb_ld(unsigned* p)              { return __hip_atomic_load(p, __ATOMIC_RELAXED, __HIP_MEMORY_SCOPE_AGENT); }
__device__ __forceinline__ unsigned xb_add(unsigned* p, unsigned v) { return __hip_atomic_fetch_add(p, v, __ATOMIC_RELAXED, __HIP_MEMORY_SCOPE_AGENT); }
__device__ __forceinline__ unsigned xb_xcc_id() { return (unsigned)__builtin_amdgcn_s_getreg((3 << 11) | 20) & 0xFu; }
#define XB_SPIN(cond, bar) do { unsigned _sp = 0; while (cond) { __builtin_amdgcn_s_sleep(1); \
    if ((++_sp & 255u) == 0u) { if (xb_ld(&(bar)[XB_TMO])) break; if (_sp > XB_SPIN_CAP) { atomicAdd(&(bar)[XB_TMO], 1u); break; } } } } while (0)

struct XcdBarrier {
    unsigned* bar; unsigned x;
    volatile LAS unsigned* st;
};

__device__ __forceinline__ XcdBarrier xcd_barrier_post(unsigned* bar, volatile LAS unsigned* st) {
    XcdBarrier b; b.bar = bar; b.x = xb_xcc_id(); b.st = st;
    if (threadIdx.x == 0) (void)xb_add(&bar[XB_XCNT(b.x)], 1u);
    return b;
}
__device__ __forceinline__ void xcd_barrier_complete(unsigned* bar, unsigned x, unsigned& nloc, unsigned& nx) {
    const unsigned G = gridDim.x * gridDim.y * gridDim.z;
    unsigned sum, cnt, mine, sp = 0u;
    for (;;) {
        sum = 0u; cnt = 0u; mine = 0u;
#pragma unroll
        for (unsigned j = 0; j < 16; ++j) { const unsigned c = xb_ld(&bar[XB_XCNT(j)]); sum += c; cnt += (c > 0u) ? 1u : 0u; mine = (j == x) ? c : mine; }
        if (sum == G) break;
        __builtin_amdgcn_s_sleep(1);
        if ((++sp & 255u) == 0u) { if (xb_ld(&bar[XB_TMO])) break; if (sp > XB_SPIN_CAP) { atomicAdd(&bar[XB_TMO], 1u); break; } }
    }
    nloc = mine > 0u ? mine : 1u; nx = cnt > 0u ? cnt : 1u;
}

__device__ __forceinline__ void xcd_barrier(const XcdBarrier& b) {
    asm volatile("s_waitcnt vmcnt(0)" ::: "memory");
    __syncthreads();
    if (threadIdx.x == 0) {
        unsigned* bar = b.bar;
        __builtin_amdgcn_s_waitcnt(0);
        unsigned nloc = b.st[0], nx = b.st[1];
        if (nloc == 0u) { xcd_barrier_complete(bar, b.x, nloc, nx); b.st[0] = nloc; b.st[1] = nx; }
        const unsigned old = xb_add(&bar[XB_XSUB(b.x)], 1u);
        const unsigned gen = old / nloc;
        if (old + 1u == (gen + 1u) * nloc) {
            __builtin_amdgcn_fence(__ATOMIC_RELEASE, "agent");
            asm volatile("s_waitcnt vmcnt(0)" ::: "memory");
            const unsigned og = xb_add(&bar[XB_TOP], 1u);
            const unsigned tg = og / nx;
            if (og + 1u == (tg + 1u) * nx) xb_add(&bar[XB_TOPGEN], 1u);
            else XB_SPIN(xb_ld(&bar[XB_TOPGEN]) == tg, bar);
            __builtin_amdgcn_fence(__ATOMIC_ACQUIRE, "agent");
            xb_add(&bar[XB_XGEN(b.x)], 1u);
            asm volatile("s_waitcnt vmcnt(0)" ::: "memory");
        } else {
            XB_SPIN(xb_ld(&bar[XB_XGEN(b.x)]) == gen, bar);
            __builtin_amdgcn_fence(__ATOMIC_ACQUIRE, "agent");
            asm volatile("s_waitcnt vmcnt(0)" ::: "memory");
        }
    }
    __syncthreads();
}
using pg8::sigmoid_f;

constexpr int BATCH = 2, SEQ = 8192, D = 1024, FF = 2816, M = BATCH * SEQ;
constexpr int NFF2 = 2 * FF;
constexpr int NMIX = 2 * D;
constexpr int LRU_HEADS = 16, LRU_HD = 64, SG_HEADS = 8, SG_HD = 128, CHUNK = 128;
constexpr float NORM_EPS = 1e-6f;
constexpr int NWAVES = 8, NTHREADS = NWAVES * 64;
#ifndef MK_N_LAUNCHES
#define MK_N_LAUNCHES 1
#endif
constexpr int N_PHASES = 17;
constexpr int N_LAUNCHES = MK_N_LAUNCHES;
static_assert(N_LAUNCHES == 1 || N_LAUNCHES == N_PHASES, "MK_N_LAUNCHES is 1 or 17");

constexpr size_t MiB = 1u << 20;
constexpr size_t WS_CTL = 0, CTL_ZERO_BYTES = 64 * 1024;
constexpr size_t WS_SSP = 1 * MiB;
constexpr size_t WS_VSSP = 2 * MiB;
constexpr size_t WS_AAGG = 3 * MiB, WS_BAGG = 4 * MiB;
constexpr size_t WS_WGT = 5 * MiB;
constexpr size_t WS_SP = 5 * MiB + 512 * 1024;
constexpr size_t WS_WST = 6 * MiB;
constexpr size_t WS_WFI = 8 * MiB;
constexpr size_t WS_WFO = 52 * MiB;
constexpr size_t WS_WMI = 74 * MiB;
constexpr size_t WS_WMO = 82 * MiB;
constexpr size_t WS_XA = 88 * MiB;
constexpr size_t WS_HID = 120 * MiB;
constexpr size_t WS_YR = 120 * MiB;
constexpr size_t WS_YH = 184 * MiB;
constexpr size_t WS_END = 216 * MiB;
static_assert(WS_WFI + 4ull * NFF2 * D * 2 <= WS_WFO && WS_WFO + 4ull * D * FF * 2 <= WS_WMI && WS_WMI + 2ull * NMIX * D * 2 <= WS_WMO && WS_WMO + 2ull * D * D * 2 <= WS_XA, "weights map");
static_assert(WS_XA + (size_t)M * D * 2 <= WS_HID && WS_HID + (size_t)M * FF * 2 <= WS_END && WS_YR + (size_t)M * NMIX * 2 <= WS_YH && WS_YH + (size_t)M * D * 2 <= WS_END, "activations map");
constexpr int CW_BAR = 1024;
static_assert((CW_BAR + XCD_BAR_WORDS) * 4 <= (int)CTL_ZERO_BYTES, "CTL words inside the memset region");

constexpr int SCR_BYTES = 139264;
constexpr int LDSCTL_OFF = SCR_BYTES;
constexpr int LDS_BYTES = SCR_BYTES + 512;

typedef unsigned u32x4 __attribute__((ext_vector_type(4)));
typedef float f32x16 __attribute__((ext_vector_type(16)));
typedef float f32x2v __attribute__((ext_vector_type(2)));
__device__ __forceinline__ unsigned cvtpk(float lo, float hi) { unsigned r; asm volatile("v_cvt_pk_bf16_f32 %0, %1, %2" : "=v"(r) : "v"(lo), "v"(hi)); return r; }
__device__ __forceinline__ float bflo(unsigned u) { return __builtin_bit_cast(float, u << 16); }
__device__ __forceinline__ float bfhi(unsigned u) { return __builtin_bit_cast(float, u & 0xffff0000u); }

struct Args { const float* in[23]; float* out; unsigned char* ws; int ph_lo, ph_hi, li, pad; };
enum { IN_X = 0, IN_FFN1_NORM, IN_FFN1_WIN, IN_FFN1_WOUT, IN_MIX_NORM, IN_FFN2_NORM, IN_FFN2_WIN, IN_FFN2_WOUT, IN_REC_WIN, IN_REC_CONVW, IN_REC_CONVB, IN_REC_GAW, IN_REC_GAB, IN_REC_GXW, IN_REC_GXB,
       IN_REC_LAMBDA, IN_REC_WOUT, IN_SG_WIN, IN_SG_VNORM, IN_SG_WS, IN_SG_BS, IN_SG_WOUT, IN_FINAL_NORM };

struct Frame {
    LAS unsigned char* lds; gu32* ctl; int tid, lane, wave, G, bid;
    const float* const* in; float* out; unsigned char* ws;
};

__device__ __forceinline__ float wave_sum(float v) {
#pragma unroll
    for (int o = 1; o < 64; o <<= 1) v += __shfl_xor(v, o);
    return v;
}

template <bool GAIN> __device__ __forceinline__ void tr_item(const float* W, int K, int ldw, int src_col0, const float* gain, bf16* WT, int dst_row0, LAS float* scr, int kb, int lane) {
    const int k0 = 64 * kb;
#pragma unroll 8
    for (int i = 0; i < 32; ++i) { const int kk = 2 * i + (lane >> 5); float w = W[(size_t)(k0 + kk) * ldw + src_col0 + (lane & 31)]; if (GAIN) w *= gain[k0 + kk]; scr[kk * 33 + (lane & 31)] = w; }
    LDS_WAIT(); asm volatile("" ::: "memory");
    const int c = lane & 7;
#pragma unroll
    for (int j = 0; j < 4; ++j) { const int n = (lane >> 3) + 8 * j; const LAS float* s = scr + (8 * c) * 33 + n;
        v4u o; o.x = cvtpk(s[0 * 33], s[1 * 33]); o.y = cvtpk(s[2 * 33], s[3 * 33]); o.z = cvtpk(s[4 * 33], s[5 * 33]); o.w = cvtpk(s[6 * 33], s[7 * 33]);
        *(GAS v4u*)(WT + (size_t)(dst_row0 + n) * K + k0 + 8 * c) = o; }
    LDS_WAIT(); asm volatile("" ::: "memory");
}
__device__ __forceinline__ void p0_prologue(Frame& F) {
    LAS float* scr = (LAS float*)(F.lds + F.wave * 16384);
    const int gw = F.bid * NWAVES + F.wave, NGW = F.G * NWAVES;
    constexpr int G_FI = NFF2 / 32, G_FO = D / 32, G_MI = NMIX / 32, G_MO = D / 32;
    constexpr int I_FI = (D / 64) * G_FI, I_FO = (FF / 64) * G_FO, I_MI = (D / 64) * G_MI, I_MO = (D / 64) * G_MO;
    constexpr int NITEMS = 4 * I_FI + 4 * I_FO + 2 * I_MI + 2 * I_MO;
    bf16* const wfi = (bf16*)(F.ws + WS_WFI); bf16* const wfo = (bf16*)(F.ws + WS_WFO); bf16* const wmi = (bf16*)(F.ws + WS_WMI); bf16* const wmo = (bf16*)(F.ws + WS_WMO);
    for (int it = gw; it < NITEMS; it += NGW) {
        int r = it;
        if (r < 4 * I_FI) {
            const int idx = r / I_FI; r -= idx * I_FI; const int l = idx >> 1, f = idx & 1;
            const int kb = r / G_FI, dg = r % G_FI, pn = dg >> 3, j0 = (dg & 7) * 32;
            const int src = (j0 < 128) ? (128 * pn + j0) : (FF + 128 * pn + (j0 - 128));
            tr_item<true>(F.in[f ? IN_FFN2_WIN : IN_FFN1_WIN] + (size_t)l * D * NFF2, D, NFF2, src, F.in[f ? IN_FFN2_NORM : IN_FFN1_NORM] + l * D, wfi + (size_t)idx * NFF2 * D, dg * 32, scr, kb, F.lane);
            continue; }
        r -= 4 * I_FI;
        if (r < 4 * I_FO) {
            const int idx = r / I_FO; r -= idx * I_FO; const int l = idx >> 1, f = idx & 1;
            const int kb = r / G_FO, dg = r % G_FO;
            tr_item<false>(F.in[f ? IN_FFN2_WOUT : IN_FFN1_WOUT] + (size_t)l * FF * D, FF, D, dg * 32, nullptr, wfo + (size_t)idx * D * FF, dg * 32, scr, kb, F.lane);
            continue; }
        r -= 4 * I_FO;
        if (r < 2 * I_MI) {
            const int l = r / I_MI; r -= l * I_MI; const int kb = r / G_MI, dg = r % G_MI;
            tr_item<true>(F.in[l ? IN_SG_WIN : IN_REC_WIN], D, NMIX, dg * 32, F.in[IN_MIX_NORM] + l * D, wmi + (size_t)l * NMIX * D, dg * 32, scr, kb, F.lane);
            continue; }
        r -= 2 * I_MI;
        { const int l = r / I_MO; r -= l * I_MO; const int kb = r / G_MO, dg = r % G_MO;
          tr_item<false>(F.in[l ? IN_SG_WOUT : IN_REC_WOUT], D, D, dg * 32, nullptr, wmo + (size_t)l * D * D, dg * 32, scr, kb, F.lane); }
    }
    { bf16* const xa = (bf16*)(F.ws + WS_XA); float* const ssp = (float*)(F.ws + WS_SSP); const float* x = F.in[IN_X];
      for (int m = gw; m < M; m += NGW) {
          const GAS f32x4* xr = (const GAS f32x4*)(x + (size_t)m * D) + F.lane; f32x4 v[4]; float s = 0.f;
#pragma unroll
          for (int j = 0; j < 4; ++j) { v[j] = xr[64 * j]; s += (v[j].x * v[j].x + v[j].y * v[j].y) + (v[j].z * v[j].z + v[j].w * v[j].w); }
          s = wave_sum(s);
          GAS unsigned long long* o8 = (GAS unsigned long long*)(xa + (size_t)m * D) + F.lane;
#pragma unroll
          for (int j = 0; j < 4; ++j) o8[64 * j] = (unsigned long long)cvtpk(v[j].x, v[j].y) | ((unsigned long long)cvtpk(v[j].z, v[j].w) << 32);
          if (F.lane < 16) ssp[(size_t)m * 16 + F.lane] = (F.lane == 0) ? s : 0.f;
      } }
    { const int gt = F.bid * NTHREADS + F.tid, NT = F.G * NTHREADS;
      bf16* const wgt = (bf16*)(F.ws + WS_WGT); float* const wst = (float*)(F.ws + WS_WST); float* const sp = (float*)(F.ws + WS_SP);
      for (int e = gt; e < 2 * LRU_HEADS * 64 * 64; e += NT) {
          const int i = e & 63, j = (e >> 6) & 63, h = (e >> 12) & 15, g = e >> 16;
          const float w = F.in[g ? IN_REC_GXW : IN_REC_GAW][(h * 64 + i) * 64 + j];
          wgt[e] = (bf16)(cvtpk(w, 0.f) & 0xffffu); }
      for (int e = gt; e < SG_HEADS * CHUNK * CHUNK; e += NT) {
          const int p = e & 127, q = (e >> 7) & 127, h = e >> 14;
          wst[e] = (q <= p) ? F.in[IN_SG_WS][(h * CHUNK + p) * CHUNK + q] : 0.f; }
      for (int e = gt; e < D; e += NT) sp[e] = log1pf(expf(-F.in[IN_REC_LAMBDA][e]));
    }
}

constexpr int SC_T = 64, SC_LD = 260, SC_NC = SEQ / SC_T;
static_assert(2 * SC_T * SC_LD * 4 <= SCR_BYTES, "scan LDS");
__device__ __forceinline__ void scan_phase(Frame& F, int pass) {
    LAS float* const XF = (LAS float*)F.lds; LAS float* const AA = XF + SC_T * SC_LD;
    const int tid = F.tid, lane = F.lane, w = F.wave;
    const bf16* const YR = (const bf16*)(F.ws + WS_YR); bf16* const YH = (bf16*)(F.ws + WS_YH);
    float* const Aagg = (float*)(F.ws + WS_AAGG); float* const Bagg = (float*)(F.ws + WS_BAGG);
    const bf16* const wgt = (const bf16*)(F.ws + WS_WGT); const float* const spv = (const float*)(F.ws + WS_SP);
    const float* const convw = F.in[IN_REC_CONVW]; const float* const convb = F.in[IN_REC_CONVB]; const float* const gab = F.in[IN_REC_GAB]; const float* const gxb = F.in[IN_REC_GXB];
    for (int it = F.bid; it < BATCH * SC_NC * 4; it += F.G) {
        const int hg = it & 3, c = (it >> 2) & (SC_NC - 1), b = it >> 9;
        const int t0 = c * SC_T, chb = hg * 256; const size_t rowb = (size_t)b * SEQ;
        { const int cp = tid & 127, tq = tid >> 7, ch = chb + 2 * cp, tl0 = tq * 16;
          const f32x2v w0 = *(const f32x2v*)(convw + 0 * D + ch), w1 = *(const f32x2v*)(convw + 1 * D + ch), w2 = *(const f32x2v*)(convw + 2 * D + ch), w3 = *(const f32x2v*)(convw + 3 * D + ch), cb = *(const f32x2v*)(convb + ch);
          unsigned raw[19];
#pragma unroll
          for (int i = 0; i < 19; ++i) { const int s = t0 + tl0 - 3 + i; const int sc = s < 0 ? 0 : s; const unsigned v = *(const unsigned*)(YR + (rowb + sc) * NMIX + D + ch); raw[i] = (s >= 0) ? v : 0u; }
#pragma unroll
          for (int i = 0; i < 16; ++i) {
              const f32x2v r3 = {bflo(raw[i]), bfhi(raw[i])}, r2 = {bflo(raw[i + 1]), bfhi(raw[i + 1])}, r1 = {bflo(raw[i + 2]), bfhi(raw[i + 2])}, r0 = {bflo(raw[i + 3]), bfhi(raw[i + 3])};
              const f32x2v o = cb + w0 * r3 + w1 * r2 + w2 * r1 + w3 * r0;
              *(LAS f32x2v*)(XF + (tl0 + i) * SC_LD + 2 * cp) = o; } }
        __syncthreads();
        { const int hd = w >> 1, th = w & 1, r32 = lane & 31, hi = lane >> 5, head = hg * 4 + hd;
          f32x16 acc[2][2];
#pragma unroll
          for (int g = 0; g < 2; ++g)
#pragma unroll
              for (int nb = 0; nb < 2; ++nb)
#pragma unroll
                  for (int r = 0; r < 16; ++r) acc[g][nb][r] = 0.f;
#pragma unroll
          for (int ks = 0; ks < 4; ++ks) {
              const LAS float* ap = XF + (th * 32 + r32) * SC_LD + hd * 64 + 16 * ks + 8 * hi;
              const f32x4 a0 = *(const LAS f32x4*)ap, a1 = *(const LAS f32x4*)(ap + 4);
              u32x4 aw; aw.x = cvtpk(a0[0], a0[1]); aw.y = cvtpk(a0[2], a0[3]); aw.z = cvtpk(a1[0], a1[1]); aw.w = cvtpk(a1[2], a1[3]);
              const bf16x8 af = __builtin_bit_cast(bf16x8, aw);
#pragma unroll
              for (int g = 0; g < 2; ++g)
#pragma unroll
                  for (int nb = 0; nb < 2; ++nb) {
                      const bf16x8 bfr = *(const bf16x8*)(wgt + ((size_t)((g * LRU_HEADS + head) * 64 + nb * 32 + r32)) * 64 + 16 * ks + 8 * hi);
                      acc[g][nb] = __builtin_amdgcn_mfma_f32_32x32x16_bf16(af, bfr, acc[g][nb], 0, 0, 0); } }
#pragma unroll
          for (int nb = 0; nb < 2; ++nb) {
              const int chl = hd * 64 + nb * 32 + r32, chg = chb + chl;
              const float ba = gab[chg], bx = gxb[chg], spc = spv[chg];
#pragma unroll
              for (int r = 0; r < 16; ++r) {
                  const int tok = th * 32 + (r & 3) + 8 * (r >> 2) + 4 * hi;
                  const float ga = sigmoid_f(acc[0][nb][r] + ba), gx = sigmoid_f(acc[1][nb][r] + bx);
                  const float la = -8.0f * ga * spc, a = __builtin_amdgcn_exp2f(1.4426950408889634f * la), z = 2.0f * la;
                  const float em_poly = z * (1.0f + z * (0.5f + z * (0.16666667f + z * (0.041666668f + z * (0.0083333338f + z * 0.0013888889f)))));
                  const float em = (z > -0.3f) ? em_poly : (a * a - 1.0f);
                  const float mult = __builtin_amdgcn_sqrtf(-em);
                  LAS float* px = XF + tok * SC_LD + chl;
                  const float xf = *px;
                  AA[tok * SC_LD + chl] = a; *px = xf * gx * mult; } } }
        __syncthreads();
        if (tid < 256) {
            const size_t ai = ((size_t)(b * SC_NC + c)) * D + chb + tid;
            if (pass == 1) {
                float P = 1.f, h = 0.f;
#pragma unroll 8
                for (int t = 0; t < SC_T; ++t) { const float a = AA[t * SC_LD + tid], bb = XF[t * SC_LD + tid]; h = a * h + bb; P *= a; }
                Aagg[ai] = P; Bagg[ai] = h;
            } else {
                float h = 0.f;
                const float* pa = Aagg + (size_t)b * SC_NC * D + chb + tid; const float* pb = Bagg + (size_t)b * SC_NC * D + chb + tid;
#pragma unroll 8
                for (int cc = 0; cc < c; ++cc) h = pa[(size_t)cc * D] * h + pb[(size_t)cc * D];
#pragma unroll 8
                for (int t = 0; t < SC_T; ++t) { const float a = AA[t * SC_LD + tid], bb = XF[t * SC_LD + tid]; h = a * h + bb; XF[t * SC_LD + tid] = h; }
            }
        }
        __syncthreads();
        if (pass == 2) {
#pragma unroll
            for (int p = 0; p < 4; ++p) {
                const int tl = p * 16 + (tid >> 5), j = tid & 31; const size_t row = rowb + t0 + tl;
                const u32x4 yv = *(const u32x4*)(YR + row * NMIX + chb + 8 * j);
                const f32x4 h0 = *(const LAS f32x4*)(XF + tl * SC_LD + 8 * j), h1 = *(const LAS f32x4*)(XF + tl * SC_LD + 8 * j + 4);
                u32x4 o; o.x = cvtpk(bflo(yv.x) * h0[0], bfhi(yv.x) * h0[1]); o.y = cvtpk(bflo(yv.y) * h0[2], bfhi(yv.y) * h0[3]);
                o.z = cvtpk(bflo(yv.z) * h1[0], bfhi(yv.z) * h1[1]); o.w = cvtpk(bflo(yv.w) * h1[2], bfhi(yv.w) * h1[3]);
                *(u32x4*)(YH + row * D + chb + 8 * j) = o; }
            __syncthreads();
        }
    }
}

constexpr int SP_LD = 128;
__device__ __forceinline__ void spatial_phase(Frame& F) {
    LAS float* const VN = (LAS float*)F.lds;
    const int tid = F.tid, lane = F.lane, w = F.wave, r32 = lane & 31, hi = lane >> 5;
    const bf16* const UV = (const bf16*)(F.ws + WS_YR); bf16* const US = (bf16*)(F.ws + WS_YH);
    const float* const vssp = (const float*)(F.ws + WS_VSSP); const float* const wst = (const float*)(F.ws + WS_WST);
    const float* const vng = F.in[IN_SG_VNORM]; const float* const bs = F.in[IN_SG_BS];
    for (int it = F.bid; it < BATCH * (SEQ / CHUNK) * SG_HEADS; it += F.G) {
        const int h = it & 7, n = (it >> 3) & 63, b = it >> 9; const size_t row0 = (size_t)b * SEQ + (size_t)n * CHUNK;
#pragma unroll
        for (int p = 0; p < 4; ++p) {
            const int q = p * 32 + (tid >> 4), j = tid & 15; const size_t row = row0 + q;
            const f32x4 s0 = *(const f32x4*)(vssp + row * 16), s1 = *(const f32x4*)(vssp + row * 16 + 4), s2 = *(const f32x4*)(vssp + row * 16 + 8), s3 = *(const f32x4*)(vssp + row * 16 + 12);
            const float ss = ((s0[0] + s0[1]) + (s0[2] + s0[3])) + ((s1[0] + s1[1]) + (s1[2] + s1[3])) + ((s2[0] + s2[1]) + (s2[2] + s2[3])) + ((s3[0] + s3[1]) + (s3[2] + s3[3]));
            const float rv = __builtin_amdgcn_rsqf(ss * (1.0f / 1024.0f) + NORM_EPS);
            const u32x4 vv = *(const u32x4*)(UV + row * NMIX + D + h * SG_HD + 8 * j);
            const f32x4 g0 = *(const f32x4*)(vng + h * SG_HD + 8 * j), g1 = *(const f32x4*)(vng + h * SG_HD + 8 * j + 4);
            f32x4 o0, o1;
            o0[0] = bflo(vv.x) * rv * g0[0]; o0[1] = bfhi(vv.x) * rv * g0[1]; o0[2] = bflo(vv.y) * rv * g0[2]; o0[3] = bfhi(vv.y) * rv * g0[3];
            o1[0] = bflo(vv.z) * rv * g1[0]; o1[1] = bfhi(vv.z) * rv * g1[1]; o1[2] = bflo(vv.w) * rv * g1[2]; o1[3] = bfhi(vv.w) * rv * g1[3];
            *(LAS f32x4*)(VN + q * SP_LD + 8 * j) = o0; *(LAS f32x4*)(VN + q * SP_LD + 8 * j + 4) = o1; }
        __syncthreads();
        const int rb = w >> 1, chh = w & 1;
        f32x16 acc0, acc1;
#pragma unroll
        for (int r = 0; r < 16; ++r) { acc0[r] = 0.f; acc1[r] = 0.f; }
        { const float* wt = wst + (size_t)h * CHUNK * CHUNK + rb * 32 + r32; const LAS float* vb = VN + chh * 64 + r32;
          const int nks = 16 * (rb + 1);
#pragma unroll 4
          for (int ks = 0; ks < nks; ++ks) { const int q = 2 * ks + hi;
              const float a = wt[q * CHUNK]; const float b0 = vb[q * SP_LD], b1 = vb[q * SP_LD + 32];
              acc0 = __builtin_amdgcn_mfma_f32_32x32x2f32(a, b0, acc0, 0, 0, 0); acc1 = __builtin_amdgcn_mfma_f32_32x32x2f32(a, b1, acc1, 0, 0, 0); } }
        __syncthreads();
#pragma unroll
        for (int r = 0; r < 16; ++r) { const int p = rb * 32 + (r & 3) + 8 * (r >> 2) + 4 * hi; const float bias = bs[h * CHUNK + p];
            VN[p * SP_LD + chh * 64 + r32] = acc0[r] + bias; VN[p * SP_LD + chh * 64 + 32 + r32] = acc1[r] + bias; }
        __syncthreads();
#pragma unroll
        for (int p = 0; p < 4; ++p) {
            const int q = p * 32 + (tid >> 4), j = tid & 15; const size_t row = row0 + q;
            const u32x4 uv = *(const u32x4*)(UV + row * NMIX + h * SG_HD + 8 * j);
            const f32x4 s0 = *(const LAS f32x4*)(VN + q * SP_LD + 8 * j), s1 = *(const LAS f32x4*)(VN + q * SP_LD + 8 * j + 4);
            u32x4 o; o.x = cvtpk(bflo(uv.x) * s0[0], bfhi(uv.x) * s0[1]); o.y = cvtpk(bflo(uv.y) * s0[2], bfhi(uv.y) * s0[3]);
            o.z = cvtpk(bflo(uv.z) * s1[0], bfhi(uv.z) * s1[1]); o.w = cvtpk(bflo(uv.w) * s1[2], bfhi(uv.w) * s1[3]);
            *(u32x4*)(US + row * D + h * SG_HD + 8 * j) = o; }
        __syncthreads();
    }
}

__device__ __forceinline__ void final_phase(Frame& F) {
    const int gw = F.bid * NWAVES + F.wave, NGW = F.G * NWAVES; const float* const g = F.in[IN_FINAL_NORM];
    f32x4 gv[4];
#pragma unroll
    for (int j = 0; j < 4; ++j) gv[j] = *((const f32x4*)g + F.lane + 64 * j);
    for (int m = gw; m < M; m += NGW) {
        GAS f32x4* xr = (GAS f32x4*)(F.out + (size_t)m * D) + F.lane; f32x4 v[4]; float s = 0.f;
#pragma unroll
        for (int j = 0; j < 4; ++j) { v[j] = xr[64 * j]; s += (v[j].x * v[j].x + v[j].y * v[j].y) + (v[j].z * v[j].z + v[j].w * v[j].w); }
        const float rinv = __builtin_amdgcn_rsqf(wave_sum(s) * (1.0f / D) + NORM_EPS);
#pragma unroll
        for (int j = 0; j < 4; ++j) xr[64 * j] = v[j] * rinv * gv[j];
    }
}

__global__ void __launch_bounds__(NTHREADS, 2) mk_fwd(Args args) {
    extern __shared__ __attribute__((aligned(16))) unsigned char lds[];
    Frame F;
    F.lds = (LAS unsigned char*)lds; F.tid = threadIdx.x; F.lane = F.tid & 63; F.wave = __builtin_amdgcn_readfirstlane(F.tid >> 6);
    F.G = gridDim.x; F.bid = blockIdx.x; F.in = args.in; F.out = args.out; F.ws = args.ws; F.ctl = (gu32*)(args.ws + WS_CTL);
    for (int u = F.tid; u < (LDS_BYTES - LDSCTL_OFF) / 4; u += NTHREADS) ((LAS unsigned*)(F.lds + LDSCTL_OFF))[u] = 0u;
    __syncthreads();
    XcdBarrier bar; bar.bar = (unsigned*)(F.ctl + CW_BAR); bar.x = 0; bar.st = nullptr;
    if (N_LAUNCHES == 1) bar = xcd_barrier_post((unsigned*)(F.ctl + CW_BAR), (volatile LAS unsigned*)(F.lds + LDSCTL_OFF) + 8);
    const int lo = args.ph_lo, hi = args.ph_hi;
#define IN(k) (lo <= (k) && (k) < hi)
#define SEAM(k) do { if (IN((k) + 1)) xcd_barrier(bar); } while (0)
#define WSP(T, off) ((T*)(args.ws + (off)))
#define FFN_IN(k, l, f) if (IN(k)) { \
        pg8::Gemm g{WSP(const bf16, WS_XA), WSP(const bf16, WS_WFI) + (size_t)(2 * (l) + (f)) * NFF2 * D, M, NFF2, D}; pg8::StaticOrder S; S.init(M, NFF2, F.G, F.bid); \
        pg8::EpiSwiGLU E{WSP(bf16, WS_HID), FF, WSP(const float, WS_SSP), NORM_EPS}; \
        pg8::gemm_phase<pg8::EpiSwiGLU, pg8::StaticOrder, true, true>(F.lds, g, S, E); SEAM(k); }
#define FFN_OUT(k, l, f, basep) if (IN(k)) { \
        pg8::Gemm g{WSP(const bf16, WS_HID), WSP(const bf16, WS_WFO) + (size_t)(2 * (l) + (f)) * D * FF, M, D, FF}; pg8::StaticOrder S; S.init(M, D, F.G, F.bid); \
        pg8::EpiRes E{(basep), args.out, WSP(bf16, WS_XA), WSP(float, WS_SSP), 0.5f}; \
        pg8::gemm_phase<pg8::EpiRes, pg8::StaticOrder, true, true>(F.lds, g, S, E); SEAM(k); }
#define MIX_IN(k, l) if (IN(k)) { \
        pg8::Gemm g{WSP(const bf16, WS_XA), WSP(const bf16, WS_WMI) + (size_t)(l) * NMIX * D, M, NMIX, D}; pg8::StaticOrder S; S.init(M, NMIX, F.G, F.bid); \
        pg8::EpiMixIn E{WSP(bf16, WS_YR), WSP(const float, WS_SSP), NORM_EPS, (l), WSP(float, WS_VSSP)}; \
        pg8::gemm_phase<pg8::EpiMixIn, pg8::StaticOrder, true, true>(F.lds, g, S, E); SEAM(k); }
#define MIX_OUT(k, l) if (IN(k)) { \
        pg8::Gemm g{WSP(const bf16, WS_YH), WSP(const bf16, WS_WMO) + (size_t)(l) * D * D, M, D, D}; pg8::StaticOrder S; S.init(M, D, F.G, F.bid); \
        pg8::EpiRes E{args.out, args.out, WSP(bf16, WS_XA), WSP(float, WS_SSP), 1.0f}; \
        pg8::gemm_phase<pg8::EpiRes, pg8::StaticOrder, true, true>(F.lds, g, S, E); SEAM(k); }

    if (IN(0)) { p0_prologue(F); SEAM(0); }
    FFN_IN(1, 0, 0)
    FFN_OUT(2, 0, 0, args.in[IN_X])
    MIX_IN(3, 0)
    if (IN(4)) { scan_phase(F, 1); SEAM(4); }
    if (IN(5)) { scan_phase(F, 2); SEAM(5); }
    MIX_OUT(6, 0)
    FFN_IN(7, 0, 1)
    FFN_OUT(8, 0, 1, args.out)
    FFN_IN(9, 1, 0)
    FFN_OUT(10, 1, 0, args.out)
    MIX_IN(11, 1)
    if (IN(12)) { spatial_phase(F); SEAM(12); }
    MIX_OUT(13, 1)
    FFN_IN(14, 1, 1)
    FFN_OUT(15, 1, 1, args.out)
    if (IN(16)) final_phase(F);
#undef IN
#undef SEAM
#undef WSP
#undef FFN_IN
#undef FFN_OUT
#undef MIX_IN
#undef MIX_OUT
}

extern "C" void kernel_launch(void* const* d_in, const int* in_sizes, int n_in, void* d_out, int out_size, void* d_ws, size_t ws_size, hipStream_t stream) {
    static int grid = 0;
    if (grid == 0) {
        if (n_in != 23 || in_sizes[0] != M * D || out_size != M * D || ws_size < WS_END) { fprintf(stderr, "kernel_launch: unexpected shapes (n_in %d, in0 %d, out %d, ws %zu); nothing launched\n", n_in, n_in > 0 ? in_sizes[0] : -1, out_size, ws_size); grid = -1; return; }
        int dev = 0, cus = 0, per_cu = 0;
        if (hipGetDevice(&dev) != hipSuccess || hipDeviceGetAttribute(&cus, hipDeviceAttributeMultiprocessorCount, dev) != hipSuccess) { fprintf(stderr, "kernel_launch: device query failed\n"); grid = -1; return; }
        if (hipFuncSetAttribute((const void*)mk_fwd, hipFuncAttributeMaxDynamicSharedMemorySize, LDS_BYTES) != hipSuccess) { fprintf(stderr, "kernel_launch: hipFuncSetAttribute failed\n"); grid = -1; return; }
        if (hipOccupancyMaxActiveBlocksPerMultiprocessor(&per_cu, (const void*)mk_fwd, NTHREADS, LDS_BYTES) != hipSuccess || per_cu < 1) { fprintf(stderr, "kernel_launch: occupancy query reports %d blocks per CU; nothing launched\n", per_cu); (void)hipGetLastError(); grid = -1; return; }
        grid = cus;
    }
    if (grid < 0) return;
    if (hipMemsetAsync((char*)d_ws + WS_CTL, 0, CTL_ZERO_BYTES, stream) != hipSuccess) { fprintf(stderr, "kernel_launch: memset failed\n"); return; }
    Args a{};
    for (int i = 0; i < 23; ++i) a.in[i] = (const float*)d_in[i];
    a.out = (float*)d_out; a.ws = (unsigned char*)d_ws;
    for (int li = 0; li < N_LAUNCHES; ++li) {
        a.ph_lo = (N_LAUNCHES == 1) ? 0 : li; a.ph_hi = (N_LAUNCHES == 1) ? N_PHASES : li + 1; a.li = li;
        hipLaunchKernelGGL(mk_fwd, dim3(grid), dim3(NTHREADS), LDS_BYTES, stream, a);
        const hipError_t le = hipPeekAtLastError();
        if (le != hipSuccess) { fprintf(stderr, "kernel_launch: launch %d failed: %s\n", li, hipGetErrorName(le)); break; }
    }
}
```

```cpp
#include <hip/hip_runtime.h>
#include <cstdio>
#include <cstdint>
#include <cmath>
namespace pg8 {
#define PG8_LAS __attribute__((address_space(3)))
typedef unsigned short bf16_t;
typedef short bf16x8 __attribute__((ext_vector_type(8)));
typedef float f32x4 __attribute__((ext_vector_type(4)));
typedef unsigned u32x4 __attribute__((ext_vector_type(4)));
constexpr int BM = 256, BK = 64, HALF = 128, HTB = HALF * BK * 2  , STAGE_BYTES = 8 * HTB, NXCD = 8, WGM = 8;

__host__ __device__ __forceinline__ int lds_byte(int r, int c) { const int st = (r >> 4) * 2 + (c >> 5), rr = r & 15, cc = c & 31, ob = rr * 64 + cc * 2; return st * 1024 + (ob ^ (((ob >> 9) & 1) << 5)); }
__host__ __device__ __forceinline__ void stage_rc(int b, int& R, int& C) { const int st = b / 1024, sb = b % 1024, swz = sb ^ (((sb >> 9) & 1) << 5); R = (st >> 1) * 16 + swz / 64; C = (st & 1) * 32 + (swz % 64) / 2; }
__host__ __device__ __forceinline__ int perm32(int rho) { const int n = rho >> 4, i = rho & 15; return 8 * (i >> 2) + 4 * n + (i & 3); }

struct Unit { int pm, pn; };
struct Gemm { const bf16_t* A; const bf16_t* Bt; int M, N, K; };

struct StaticOrder {
    int nM, nN, nwg, G, c;
    __host__ __device__ void init(int M, int N, int G_, int c_) { nM = M / BM; nN = N / BM; nwg = nM * nN; G = G_; c = c_; }
    __host__ __device__ bool next(int i, Unit& u) const {
        const long L = (long)i * G + c; if (L >= nwg) return false;
        int wgid = (int)L; { const int q = nwg / NXCD, r = nwg % NXCD, xcd = wgid % NXCD, off = wgid / NXCD; wgid = (xcd < r ? xcd * (q + 1) : r * (q + 1) + (xcd - r) * q) + off; }
        const int nig = WGM * nN, gid = wgid / nig, fm = gid * WGM, gsz = (nM - fm) < WGM ? (nM - fm) : WGM;
        u.pm = fm + ((wgid % nig) % gsz); u.pn = (wgid % nig) / gsz; return true;
    }
    __device__ __forceinline__ void a_ready(const Unit&) const {}
    __device__ __forceinline__ void done(const Unit&) const {}
};

__device__ __forceinline__ unsigned cvt_pk_bf16(float lo, float hi) { unsigned r; asm volatile("v_cvt_pk_bf16_f32 %0, %1, %2" : "=v"(r) : "v"(lo), "v"(hi)); return r; }
typedef float f32x2 __attribute__((ext_vector_type(2)));
__device__ __forceinline__ float sigmoid_f(float x) { return __builtin_amdgcn_rcpf(1.0f + __builtin_amdgcn_exp2f(-1.4426950408889634f * x)); }
__device__ __forceinline__ float silu_f(float x) { return x * sigmoid_f(x); }
__device__ __forceinline__ float gelu_f(float x) {
    const float u = x * (1.0f + 0.044715f * x * x);
    return x * __builtin_amdgcn_rcpf(1.0f + __builtin_amdgcn_exp2f(-2.302208198f * u));
}
__device__ __forceinline__ void load_rinv(float (&ri)[2][4], const float* ssp, int pm, int wr, int fr, int fq, float eps) {
#pragma unroll
    for (int ai = 0; ai < 2; ++ai)
#pragma unroll
        for (int m = 0; m < 4; ++m) {
            const f32x4 v = *(const f32x4*)(ssp + (size_t)(pm * BM + ai * HALF + wr * 64 + m * 16 + fr) * 16 + 4 * fq);
            float s = (v[0] + v[1]) + (v[2] + v[3]);
            s += __shfl_xor(s, 16); s += __shfl_xor(s, 32);
            ri[ai][m] = __builtin_amdgcn_rsqf(s * (1.0f / 1024.0f) + eps);
        }
}
struct EpiSwiGLU {
    static constexpr bool PERM = true, AFTER_DRAIN = false;
    bf16_t* H; int ldh; const float* ssp; float eps;
    __device__ __forceinline__ void operator()(const f32x4 (&acc)[2][2][4][2], const Unit& u, int wr, int wc, int fr, int fq) const {
        float ri[2][4]; load_rinv(ri, ssp, u.pm, wr, fr, fq, eps);
        const int col0 = u.pn * HALF + wc * 32 + 8 * fq;
#pragma unroll
        for (int ai = 0; ai < 2; ++ai)
#pragma unroll
            for (int m = 0; m < 4; ++m) {
                const int row = u.pm * BM + ai * HALF + wr * 64 + m * 16 + fr; const float r = ri[ai][m];
                const f32x4 g0 = acc[ai][0][m][0] * r, g1 = acc[ai][0][m][1] * r, u0 = acc[ai][1][m][0] * r, u1 = acc[ai][1][m][1] * r;
                u32x4 w;
                w.x = cvt_pk_bf16(silu_f(g0[0]) * u0[0], silu_f(g0[1]) * u0[1]); w.y = cvt_pk_bf16(silu_f(g0[2]) * u0[2], silu_f(g0[3]) * u0[3]);
                w.z = cvt_pk_bf16(silu_f(g1[0]) * u1[0], silu_f(g1[1]) * u1[1]); w.w = cvt_pk_bf16(silu_f(g1[2]) * u1[2], silu_f(g1[3]) * u1[3]);
                *(u32x4*)(H + (size_t)row * ldh + col0) = w;
            }
    }
};
struct EpiRes {
    static constexpr bool PERM = true, AFTER_DRAIN = false;
    bf16_t* xa; float* ssp_out; float alpha;
    __device__ __forceinline__ void operator()(const f32x4 (&acc)[2][2][4][2], const Unit& u, int wr, int wc, int fr, int fq) const {
        const int col0 = u.pn * BM + wc * 32 + 8 * fq;
#pragma unroll
        for (int ai = 0; ai < 2; ++ai)
#pragma unroll
            for (int m = 0; m < 4; ++m) {
                const int row = u.pm * BM + ai * HALF + wr * 64 + m * 16 + fr; float ss = 0.f;
#pragma unroll
                for (int bj = 0; bj < 2; ++bj) {
                    const size_t off = (size_t)row * 1024 + col0 + bj * HALF;
                    const u32x4 b = *(const u32x4*)(xa + off);
                    f32x4 v0, v1;
                    v0[0] = __builtin_bit_cast(float, b.x << 16) + acc[ai][bj][m][0][0] * alpha; v0[1] = __builtin_bit_cast(float, b.x & 0xffff0000u) + acc[ai][bj][m][0][1] * alpha;
                    v0[2] = __builtin_bit_cast(float, b.y << 16) + acc[ai][bj][m][0][2] * alpha; v0[3] = __builtin_bit_cast(float, b.y & 0xffff0000u) + acc[ai][bj][m][0][3] * alpha;
                    v1[0] = __builtin_bit_cast(float, b.z << 16) + acc[ai][bj][m][1][0] * alpha; v1[1] = __builtin_bit_cast(float, b.z & 0xffff0000u) + acc[ai][bj][m][1][1] * alpha;
                    v1[2] = __builtin_bit_cast(float, b.w << 16) + acc[ai][bj][m][1][2] * alpha; v1[3] = __builtin_bit_cast(float, b.w & 0xffff0000u) + acc[ai][bj][m][1][3] * alpha;
                    u32x4 w; w.x = cvt_pk_bf16(v0[0], v0[1]); w.y = cvt_pk_bf16(v0[2], v0[3]); w.z = cvt_pk_bf16(v1[0], v1[1]); w.w = cvt_pk_bf16(v1[2], v1[3]);
                    *(u32x4*)(xa + off) = w;
                    ss += (v0[0] * v0[0] + v0[1] * v0[1]) + (v0[2] * v0[2] + v0[3] * v0[3]) + (v1[0] * v1[0] + v1[1] * v1[1]) + (v1[2] * v1[2] + v1[3] * v1[3]);
                }
                ss += __shfl_xor(ss, 16); ss += __shfl_xor(ss, 32);
                if (fq == 0) ssp_out[(size_t)row * 16 + u.pn * 4 + wc] = ss;
            }
    }
};
struct EpiMixIn {
    static constexpr bool PERM = true, AFTER_DRAIN = false;
    bf16_t* O; const float* ssp; float eps; int mode; float* vssp;
    __device__ __forceinline__ void operator()(const f32x4 (&acc)[2][2][4][2], const Unit& u, int wr, int wc, int fr, int fq) const {
        float ri[2][4]; load_rinv(ri, ssp, u.pm, wr, fr, fq, eps);
        const int col0 = u.pn * BM + wc * 32 + 8 * fq;
        const bool act = (mode == 1) || (u.pn < 4), vs = (mode == 1) && (u.pn >= 4);
#pragma unroll
        for (int ai = 0; ai < 2; ++ai)
#pragma unroll
            for (int m = 0; m < 4; ++m) {
                const int row = u.pm * BM + ai * HALF + wr * 64 + m * 16 + fr; const float r = ri[ai][m]; float ss = 0.f;
#pragma unroll
                for (int bj = 0; bj < 2; ++bj) {
                    f32x4 v0 = acc[ai][bj][m][0] * r, v1 = acc[ai][bj][m][1] * r;
                    if (act) {
#pragma unroll
                        for (int j = 0; j < 4; ++j) { v0[j] = gelu_f(v0[j]); v1[j] = gelu_f(v1[j]); }
                    }
                    ss += (v0[0] * v0[0] + v0[1] * v0[1]) + (v0[2] * v0[2] + v0[3] * v0[3]) + (v1[0] * v1[0] + v1[1] * v1[1]) + (v1[2] * v1[2] + v1[3] * v1[3]);
                    u32x4 w; w.x = cvt_pk_bf16(v0[0], v0[1]); w.y = cvt_pk_bf16(v0[2], v0[3]); w.z = cvt_pk_bf16(v1[0], v1[1]); w.w = cvt_pk_bf16(v1[2], v1[3]);
                    *(u32x4*)(O + (size_t)row * 2048 + col0 + bj * HALF) = w;
                }
                if (vs) { ss += __shfl_xor(ss, 16); ss += __shfl_xor(ss, 32); if (fq == 0) vssp[(size_t)row * 16 + (u.pn - 4) * 4 + wc] = ss; }
            }
    }
};

template <class Epi, class Sched, bool ALIGN_EPI = false, bool SP2 = false>
__device__ __forceinline__ void gemm_phase(PG8_LAS unsigned char* lds, const Gemm g, const Sched& S, const Epi& E) {
    const int tid = threadIdx.x, wid = __builtin_amdgcn_readfirstlane(tid >> 6), lane = tid & 63, wr = wid >> 2, wc = wid & 3, fr = lane & 15, fq = lane >> 4;
    const int K = g.K, nt = K / BK;
    unsigned voffA[2], voffB[2];
#pragma unroll
    for (int i = 0; i < 2; ++i) { int R, C; stage_rc(tid * 16 + i * 8192, R, C); const int Rb = Epi::PERM ? ((R & ~31) + perm32(R & 31)) : R;
        voffA[i] = (unsigned)(R * K + C) * 2u; voffB[i] = (unsigned)(Rb * K + C) * 2u; }
    const size_t kstep = (size_t)(BK * 2);
    const size_t hstep = (size_t)HALF * K * 2;
    const size_t tstep = 2 * hstep;
    const unsigned ldsw = (unsigned)wid * 1024u;
    const int aoff = lds_byte(wr * 64 + fr, fq * 8), boff = lds_byte(wc * 32 + fr, fq * 8);
#define PG8_SA(b, h) (((b) * 2 + (h)) * HTB)
#define PG8_SB(b, h) ((4 + (b) * 2 + (h)) * HTB)
#define PG8_STAGE(bufoff, gbase, voff) do { _Pragma("unroll") for (int _i = 0; _i < 2; ++_i) \
        __builtin_amdgcn_global_load_lds((const unsigned*)((const char*)(gbase) + (voff)[_i]), (PG8_LAS unsigned*)(lds + (bufoff) + ldsw + _i * 8192), 16, 0, 0); } while (0)
#define PG8_LDA(dst, b, h) do { _Pragma("unroll") for (int m = 0; m < 4; ++m) _Pragma("unroll") for (int k = 0; k < 2; ++k) dst[m][k] = *(const PG8_LAS bf16x8*)(lds + PG8_SA(b, h) + aoff + m * 2048 + k * 1024); } while (0)
#define PG8_LDB(dst, b, h) do { _Pragma("unroll") for (int n = 0; n < 2; ++n) _Pragma("unroll") for (int k = 0; k < 2; ++k) dst[n][k] = *(const PG8_LAS bf16x8*)(lds + PG8_SB(b, h) + boff + n * 2048 + k * 1024); } while (0)
#define PG8_MMA(ai, bj, At, Bt) do { __builtin_amdgcn_s_setprio(1); _Pragma("unroll") for (int m = 0; m < 4; ++m) _Pragma("unroll") for (int n = 0; n < 2; ++n) _Pragma("unroll") for (int k = 0; k < 2; ++k) \
        acc[ai][bj][m][n] = __builtin_amdgcn_mfma_f32_16x16x32_bf16(Bt[n][k], At[m][k], acc[ai][bj][m][n], 0, 0, 0); __builtin_amdgcn_s_setprio(0); } while (0)
#define PG8_WAIT_V(n) asm volatile("s_waitcnt vmcnt(" #n ")" ::: "memory")
#define PG8_WAIT_L(n) asm volatile("s_waitcnt lgkmcnt(" #n ")" ::: "memory")
#define PG8_BAR __builtin_amdgcn_s_barrier()
#define PG8_SCHED __builtin_amdgcn_sched_barrier(0)
    Unit cur, nxt; int ui = 0;
    if (!S.next(0, cur)) return;
    f32x4 acc[2][2][4][2];
#pragma unroll
    for (int a = 0; a < 2; ++a)
#pragma unroll
        for (int b = 0; b < 2; ++b)
#pragma unroll
            for (int m = 0; m < 4; ++m)
#pragma unroll
                for (int n = 0; n < 2; ++n) acc[a][b][m][n] = (f32x4){0.f, 0.f, 0.f, 0.f};
    bf16x8 At[4][2], B0[2][2], B1[2][2];
    const char* cA = (const char*)g.A + (size_t)cur.pm * tstep; const char* cB = (const char*)g.Bt + (size_t)cur.pn * tstep;
    S.a_ready(cur);
    if constexpr (SP2) {
        PG8_STAGE(PG8_SB(0, 0), cB, voffB); PG8_STAGE(PG8_SB(0, 1), cB + hstep, voffB); PG8_STAGE(PG8_SA(0, 0), cA, voffA); PG8_STAGE(PG8_SA(0, 1), cA + hstep, voffA);
        if (wr == 1) PG8_BAR;
        PG8_WAIT_V(2); PG8_BAR;
        PG8_STAGE(PG8_SB(1, 0), cB + kstep, voffB); PG8_STAGE(PG8_SA(1, 0), cA + kstep, voffA); PG8_STAGE(PG8_SB(1, 1), cB + hstep + kstep, voffB);
        PG8_WAIT_V(6); PG8_BAR;
    } else {
        PG8_STAGE(PG8_SB(0, 0), cB, voffB); PG8_STAGE(PG8_SA(0, 0), cA, voffA); PG8_STAGE(PG8_SB(0, 1), cB + hstep, voffB); PG8_STAGE(PG8_SA(0, 1), cA + hstep, voffA);
        if (wr == 1) PG8_BAR;
        PG8_WAIT_V(4); PG8_BAR;
        PG8_STAGE(PG8_SB(1, 0), cB + kstep, voffB); PG8_STAGE(PG8_SA(1, 0), cA + kstep, voffA); PG8_STAGE(PG8_SB(1, 1), cB + hstep + kstep, voffB);
        PG8_WAIT_V(6); PG8_BAR;
    }
    for (;;) {
        const bool has_next = S.next(ui + 1, nxt);
        const char* nA = has_next ? (const char*)g.A + (size_t)nxt.pm * tstep : cA; const char* nB = has_next ? (const char*)g.Bt + (size_t)nxt.pn * tstep : cB;
        for (int t = 0; t < nt; t += 2) {
            const bool last = (t == nt - 2);
            const char* a1 = cA + (size_t)(t + 1) * kstep;
            const char* a2 = last ? nA : cA + (size_t)(t + 2) * kstep; const char* b2 = last ? nB : cB + (size_t)(t + 2) * kstep;
            const char* a3 = a2 + kstep; const char* b3 = b2 + kstep;
            if (last && has_next) S.a_ready(nxt);
            if constexpr (SP2) {
            PG8_LDB(B0, 0, 0); PG8_LDB(B1, 0, 1); PG8_SCHED; PG8_LDA(At, 0, 0); PG8_STAGE(PG8_SA(1, 1), a1 + hstep, voffA);
            PG8_WAIT_V(8); PG8_WAIT_L(0); PG8_BAR; PG8_MMA(0, 0, At, B0); PG8_MMA(0, 1, At, B1); PG8_BAR; PG8_SCHED;
            PG8_LDA(At, 0, 1); PG8_STAGE(PG8_SB(0, 0), b2, voffB); PG8_STAGE(PG8_SB(0, 1), b2 + hstep, voffB); PG8_STAGE(PG8_SA(0, 0), a2, voffA);
            PG8_WAIT_V(8); PG8_WAIT_L(0); PG8_BAR; PG8_MMA(1, 0, At, B0); PG8_MMA(1, 1, At, B1); PG8_BAR; PG8_SCHED;
            PG8_LDB(B0, 1, 0); PG8_LDB(B1, 1, 1); PG8_SCHED; PG8_LDA(At, 1, 0); PG8_STAGE(PG8_SA(0, 1), a2 + hstep, voffA);
            PG8_WAIT_V(8); PG8_WAIT_L(0); PG8_BAR; PG8_MMA(0, 0, At, B0); PG8_MMA(0, 1, At, B1); PG8_BAR; PG8_SCHED;
            PG8_LDA(At, 1, 1); PG8_STAGE(PG8_SB(1, 0), b3, voffB); PG8_STAGE(PG8_SB(1, 1), b3 + hstep, voffB); PG8_STAGE(PG8_SA(1, 0), a3, voffA);
            PG8_WAIT_V(8); PG8_WAIT_L(0); PG8_BAR; PG8_MMA(1, 0, At, B0); PG8_MMA(1, 1, At, B1); PG8_BAR; PG8_SCHED;
            } else {
            PG8_LDB(B0, 0, 0); PG8_SCHED; PG8_LDA(At, 0, 0); PG8_STAGE(PG8_SA(1, 1), a1 + hstep, voffA);
            PG8_WAIT_L(8); PG8_BAR; PG8_WAIT_L(0); PG8_MMA(0, 0, At, B0); PG8_BAR; PG8_SCHED;
            PG8_LDB(B1, 0, 1); PG8_STAGE(PG8_SB(0, 0), b2, voffB);
            PG8_BAR; PG8_WAIT_L(0); PG8_MMA(0, 1, At, B1); PG8_BAR;
            PG8_LDA(At, 0, 1); PG8_STAGE(PG8_SA(0, 0), a2, voffA);
            PG8_BAR; PG8_WAIT_L(0); PG8_MMA(1, 0, At, B0); PG8_BAR; PG8_SCHED;
            PG8_STAGE(PG8_SB(0, 1), b2 + hstep, voffB);
            PG8_WAIT_V(6); PG8_BAR; PG8_MMA(1, 1, At, B1); PG8_BAR;
            PG8_LDB(B0, 1, 0); PG8_SCHED; PG8_LDA(At, 1, 0); PG8_STAGE(PG8_SA(0, 1), a2 + hstep, voffA);
            PG8_WAIT_L(8); PG8_BAR; PG8_WAIT_L(0); PG8_MMA(0, 0, At, B0); PG8_BAR; PG8_SCHED;
            PG8_LDB(B1, 1, 1); PG8_STAGE(PG8_SB(1, 0), b3, voffB);
            PG8_BAR; PG8_WAIT_L(0); PG8_MMA(0, 1, At, B1); PG8_BAR;
            PG8_LDA(At, 1, 1); PG8_STAGE(PG8_SA(1, 0), a3, voffA);
            PG8_BAR; PG8_WAIT_L(0); PG8_MMA(1, 0, At, B0); PG8_BAR; PG8_SCHED;
            PG8_STAGE(PG8_SB(1, 1), b3 + hstep, voffB);
            PG8_WAIT_V(6); PG8_BAR; PG8_MMA(1, 1, At, B1); PG8_BAR;
            }
        }
        if constexpr (ALIGN_EPI) { if (wr == 0) PG8_BAR; }
        if constexpr (!Epi::AFTER_DRAIN) { E(acc, cur, wr, wc, fr, fq); S.done(cur); }
        if (!has_next) break;
#pragma unroll
        for (int a = 0; a < 2; ++a)
#pragma unroll
            for (int b = 0; b < 2; ++b)
#pragma unroll
                for (int m = 0; m < 4; ++m)
#pragma unroll
                    for (int n = 0; n < 2; ++n) acc[a][b][m][n] = (f32x4){0.f, 0.f, 0.f, 0.f};
        cur = nxt; cA = nA; cB = nB; ++ui;
        if constexpr (ALIGN_EPI) { if (wr == 1) PG8_BAR; }
    }
    PG8_WAIT_V(0);
    if constexpr (!ALIGN_EPI) { if (wr == 0) PG8_BAR; }
    PG8_BAR;
    if constexpr (Epi::AFTER_DRAIN) { E.fused(acc, cur, wr, wc, fr, fq, lds, wid, lane); S.done(cur); }
#undef PG8_SA
#undef PG8_SB
#undef PG8_STAGE
#undef PG8_LDA
#undef PG8_LDB
#undef PG8_MMA
#undef PG8_WAIT_V
#undef PG8_WAIT_L
#undef PG8_BAR
#undef PG8_SCHED
}
}
#define GAS __attribute__((address_space(1)))
#define LAS __attribute__((address_space(3)))
typedef unsigned short bf16;
typedef unsigned v4u __attribute__((ext_vector_type(4)));
typedef float f32x4 __attribute__((ext_vector_type(4)));
typedef short bf16x8 __attribute__((ext_vector_type(8)));
typedef GAS unsigned gu32;
typedef GAS unsigned long long gu64;
#define RLX_AGENT __ATOMIC_RELAXED, __HIP_MEMORY_SCOPE_AGENT
#define LDS_WAIT() asm volatile("s_waitcnt lgkmcnt(0)" ::: "memory")
#define VM_WAIT() asm volatile("s_waitcnt vmcnt(0)" ::: "memory")
__device__ __forceinline__ unsigned long long rt() { return __builtin_amdgcn_s_memrealtime(); }
__device__ __forceinline__ unsigned f2bf(float f) { unsigned u = __builtin_bit_cast(unsigned, f); return (u + 0x7fffu + ((u >> 16) & 1u)) >> 16; }
__device__ __forceinline__ unsigned pk2(float lo, float hi) { return f2bf(lo) | (f2bf(hi) << 16); }

#define XB_TMO      128
#define XB_XCNT(j)  (256  + 64 * (j))
#define XB_XSUB(j)  (1280 + 64 * (j))
#define XB_XGEN(j)  (2304 + 64 * (j))
#define XB_TOP      3328
#define XB_TOPGEN   3392
#define XCD_BAR_WORDS 3456
#define XB_SPIN_CAP (1u << 18)

__device__ __forceinline__ unsigned xb_ld(unsigned* p)              { return __hip_atomic_load(p, __ATOMIC_RELAXED, __HIP_MEMORY_SCOPE_AGENT); }
__device__ __forceinline__ unsigned xb_add(unsigned* p, unsigned v) { return __hip_atomic_fetch_add(p, v, __ATOMIC_RELAXED, __HIP_MEMORY_SCOPE_AGENT); }
__device__ __forceinline__ unsigned xb_xcc_id() { return (unsigned)__builtin_amdgcn_s_getreg((3 << 11) | 20) & 0xFu; }
#define XB_SPIN(cond, bar) do { unsigned _sp = 0; while (cond) { __builtin_amdgcn_s_sleep(1); \
    if ((++_sp & 255u) == 0u) { if (xb_ld(&(bar)[XB_TMO])) break; if (_sp > XB_SPIN_CAP) { atomicAdd(&(bar)[XB_TMO], 1u); break; } } } } while (0)

struct XcdBarrier {
    unsigned* bar; unsigned x;
    volatile LAS unsigned* st;
};

__device__ __forceinline__ XcdBarrier xcd_barrier_post(unsigned* bar, volatile LAS unsigned* st) {
    XcdBarrier b; b.bar = bar; b.x = xb_xcc_id(); b.st = st;
    if (threadIdx.x == 0) (void)xb_add(&bar[XB_XCNT(b.x)], 1u);
    return b;
}
__device__ __forceinline__ void xcd_barrier_complete(unsigned* bar, unsigned x, unsigned& nloc, unsigned& nx) {
    const unsigned G = gridDim.x * gridDim.y * gridDim.z;
    unsigned sum, cnt, mine, sp = 0u;
    for (;;) {
        sum = 0u; cnt = 0u; mine = 0u;
#pragma unroll
        for (unsigned j = 0; j < 16; ++j) { const unsigned c = xb_ld(&bar[XB_XCNT(j)]); sum += c; cnt += (c > 0u) ? 1u : 0u; mine = (j == x) ? c : mine; }
        if (sum == G) break;
        __builtin_amdgcn_s_sleep(1);
        if ((++sp & 255u) == 0u) { if (xb_ld(&bar[XB_TMO])) break; if (sp > XB_SPIN_CAP) { atomicAdd(&bar[XB_TMO], 1u); break; } }
    }
    nloc = mine > 0u ? mine : 1u; nx = cnt > 0u ? cnt : 1u;
}

__device__ __forceinline__ void xcd_barrier(const XcdBarrier& b) {
    asm volatile("s_waitcnt vmcnt(0)" ::: "memory");
    __syncthreads();
    if (threadIdx.x == 0) {
        unsigned* bar = b.bar;
        __builtin_amdgcn_s_waitcnt(0);
        unsigned nloc = b.st[0], nx = b.st[1];
        if (nloc == 0u) { xcd_barrier_complete(bar, b.x, nloc, nx); b.st[0] = nloc; b.st[1] = nx; }
        const unsigned old = xb_add(&bar[XB_XSUB(b.x)], 1u);
        const unsigned gen = old / nloc;
        if (old + 1u == (gen + 1u) * nloc) {
            __builtin_amdgcn_fence(__ATOMIC_RELEASE, "agent");
            asm volatile("s_waitcnt vmcnt(0)" ::: "memory");
            const unsigned og = xb_add(&bar[XB_TOP], 1u);
            const unsigned tg = og / nx;
            if (og + 1u == (tg + 1u) * nx) xb_add(&bar[XB_TOPGEN], 1u);
            else XB_SPIN(xb_ld(&bar[XB_TOPGEN]) == tg, bar);
            __builtin_amdgcn_fence(__ATOMIC_ACQUIRE, "agent");
            xb_add(&bar[XB_XGEN(b.x)], 1u);
            asm volatile("s_waitcnt vmcnt(0)" ::: "memory");
        } else {
            XB_SPIN(xb_ld(&bar[XB_XGEN(b.x)]) == gen, bar);
            __builtin_amdgcn_fence(__ATOMIC_ACQUIRE, "agent");
            asm volatile("s_waitcnt vmcnt(0)" ::: "memory");
        }
    }
    __syncthreads();
}
using pg8::sigmoid_f;

constexpr int BATCH = 2, SEQ = 8192, D = 1024, FF = 2816, M = BATCH * SEQ;
constexpr int NFF2 = 2 * FF;
constexpr int NMIX = 2 * D;
constexpr int LRU_HEADS = 16, LRU_HD = 64, SG_HEADS = 8, SG_HD = 128, CHUNK = 128;
constexpr float NORM_EPS = 1e-6f;
constexpr int NWAVES = 8, NTHREADS = NWAVES * 64;
#ifndef MK_N_LAUNCHES
#define MK_N_LAUNCHES 1
#endif
constexpr int N_PHASES = 17;
constexpr int N_LAUNCHES = MK_N_LAUNCHES;
static_assert(N_LAUNCHES == 1 || N_LAUNCHES == N_PHASES, "MK_N_LAUNCHES is 1 or 17");

constexpr size_t MiB = 1u << 20;
constexpr size_t WS_CTL = 0, CTL_ZERO_BYTES = 64 * 1024;
constexpr size_t WS_SSP = 1 * MiB;
constexpr size_t WS_VSSP = 2 * MiB;
constexpr size_t WS_AAGG = 3 * MiB, WS_BAGG = 4 * MiB;
constexpr size_t WS_WGT = 5 * MiB;
constexpr size_t WS_SP = 5 * MiB + 512 * 1024;
constexpr size_t WS_WST = 6 * MiB;
constexpr size_t WS_WFI = 8 * MiB;
constexpr size_t WS_WFO = 52 * MiB;
constexpr size_t WS_WMI = 74 * MiB;
constexpr size_t WS_WMO = 82 * MiB;
constexpr size_t WS_XA = 88 * MiB;
constexpr size_t WS_HID = 120 * MiB;
constexpr size_t WS_YR = 120 * MiB;
constexpr size_t WS_YH = 184 * MiB;
constexpr size_t WS_END = 216 * MiB;
static_assert(WS_WFI + 4ull * NFF2 * D * 2 <= WS_WFO && WS_WFO + 4ull * D * FF * 2 <= WS_WMI && WS_WMI + 2ull * NMIX * D * 2 <= WS_WMO && WS_WMO + 2ull * D * D * 2 <= WS_XA, "weights map");
static_assert(WS_XA + (size_t)M * D * 2 <= WS_HID && WS_HID + (size_t)M * FF * 2 <= WS_END && WS_YR + (size_t)M * NMIX * 2 <= WS_YH && WS_YH + (size_t)M * D * 2 <= WS_END, "activations map");
constexpr int CW_BAR = 1024;
static_assert((CW_BAR + XCD_BAR_WORDS) * 4 <= (int)CTL_ZERO_BYTES, "CTL words inside the memset region");

constexpr int SCR_BYTES = 139264;
constexpr int LDSCTL_OFF = SCR_BYTES;
constexpr int LDS_BYTES = SCR_BYTES + 512;

typedef unsigned u32x4 __attribute__((ext_vector_type(4)));
typedef float f32x16 __attribute__((ext_vector_type(16)));
typedef float f32x2v __attribute__((ext_vector_type(2)));
__device__ __forceinline__ unsigned cvtpk(float lo, float hi) { unsigned r; asm volatile("v_cvt_pk_bf16_f32 %0, %1, %2" : "=v"(r) : "v"(lo), "v"(hi)); return r; }
__device__ __forceinline__ float bflo(unsigned u) { return __builtin_bit_cast(float, u << 16); }
__device__ __forceinline__ float bfhi(unsigned u) { return __builtin_bit_cast(float, u & 0xffff0000u); }

struct Args { const float* in[23]; float* out; unsigned char* ws; int ph_lo, ph_hi, li, pad; };
enum { IN_X = 0, IN_FFN1_NORM, IN_FFN1_WIN, IN_FFN1_WOUT, IN_MIX_NORM, IN_FFN2_NORM, IN_FFN2_WIN, IN_FFN2_WOUT, IN_REC_WIN, IN_REC_CONVW, IN_REC_CONVB, IN_REC_GAW, IN_REC_GAB, IN_REC_GXW, IN_REC_GXB,
       IN_REC_LAMBDA, IN_REC_WOUT, IN_SG_WIN, IN_SG_VNORM, IN_SG_WS, IN_SG_BS, IN_SG_WOUT, IN_FINAL_NORM };

struct Frame {
    LAS unsigned char* lds; gu32* ctl; int tid, lane, wave, G, bid;
    const float* const* in; float* out; unsigned char* ws;
};

__device__ __forceinline__ float wave_sum(float v) {
#pragma unroll
    for (int o = 1; o < 64; o <<= 1) v += __shfl_xor(v, o);
    return v;
}

template <bool GAIN> __device__ __forceinline__ void tr_item(const float* W, int K, int ldw, int src_col0, const float* gain, bf16* WT, int dst_row0, LAS float* scr, int kb, int lane) {
    const int k0 = 64 * kb;
#pragma unroll 8
    for (int i = 0; i < 32; ++i) { const int kk = 2 * i + (lane >> 5); float w = W[(size_t)(k0 + kk) * ldw + src_col0 + (lane & 31)]; if (GAIN) w *= gain[k0 + kk]; scr[kk * 33 + (lane & 31)] = w; }
    LDS_WAIT(); asm volatile("" ::: "memory");
    const int c = lane & 7;
#pragma unroll
    for (int j = 0; j < 4; ++j) { const int n = (lane >> 3) + 8 * j; const LAS float* s = scr + (8 * c) * 33 + n;
        v4u o; o.x = cvtpk(s[0 * 33], s[1 * 33]); o.y = cvtpk(s[2 * 33], s[3 * 33]); o.z = cvtpk(s[4 * 33], s[5 * 33]); o.w = cvtpk(s[6 * 33], s[7 * 33]);
        *(GAS v4u*)(WT + (size_t)(dst_row0 + n) * K + k0 + 8 * c) = o; }
    LDS_WAIT(); asm volatile("" ::: "memory");
}
__device__ __forceinline__ void p0_prologue(Frame& F) {
    LAS float* scr = (LAS float*)(F.lds + F.wave * 16384);
    const int gw = F.bid * NWAVES + F.wave, NGW = F.G * NWAVES;
    constexpr int G_FI = NFF2 / 32, G_FO = D / 32, G_MI = NMIX / 32, G_MO = D / 32;
    constexpr int I_FI = (D / 64) * G_FI, I_FO = (FF / 64) * G_FO, I_MI = (D / 64) * G_MI, I_MO = (D / 64) * G_MO;
    constexpr int NITEMS = 4 * I_FI + 4 * I_FO + 2 * I_MI + 2 * I_MO;
    bf16* const wfi = (bf16*)(F.ws + WS_WFI); bf16* const wfo = (bf16*)(F.ws + WS_WFO); bf16* const wmi = (bf16*)(F.ws + WS_WMI); bf16* const wmo = (bf16*)(F.ws + WS_WMO);
    for (int it = gw; it < NITEMS; it += NGW) {
        int r = it;
        if (r < 4 * I_FI) {
            const int idx = r / I_FI; r -= idx * I_FI; const int l = idx >> 1, f = idx & 1;
            const int kb = r / G_FI, dg = r % G_FI, pn = dg >> 3, j0 = (dg & 7) * 32;
            const int src = (j0 < 128) ? (128 * pn + j0) : (FF + 128 * pn + (j0 - 128));
            tr_item<true>(F.in[f ? IN_FFN2_WIN : IN_FFN1_WIN] + (size_t)l * D * NFF2, D, NFF2, src, F.in[f ? IN_FFN2_NORM : IN_FFN1_NORM] + l * D, wfi + (size_t)idx * NFF2 * D, dg * 32, scr, kb, F.lane);
            continue; }
        r -= 4 * I_FI;
        if (r < 4 * I_FO) {
            const int idx = r / I_FO; r -= idx * I_FO; const int l = idx >> 1, f = idx & 1;
            const int kb = r / G_FO, dg = r % G_FO;
            tr_item<false>(F.in[f ? IN_FFN2_WOUT : IN_FFN1_WOUT] + (size_t)l * FF * D, FF, D, dg * 32, nullptr, wfo + (size_t)idx * D * FF, dg * 32, scr, kb, F.lane);
            continue; }
        r -= 4 * I_FO;
        if (r < 2 * I_MI) {
            const int l = r / I_MI; r -= l * I_MI; const int kb = r / G_MI, dg = r % G_MI;
            tr_item<true>(F.in[l ? IN_SG_WIN : IN_REC_WIN], D, NMIX, dg * 32, F.in[IN_MIX_NORM] + l * D, wmi + (size_t)l * NMIX * D, dg * 32, scr, kb, F.lane);
            continue; }
        r -= 2 * I_MI;
        { const int l = r / I_MO; r -= l * I_MO; const int kb = r / G_MO, dg = r % G_MO;
          tr_item<false>(F.in[l ? IN_SG_WOUT : IN_REC_WOUT], D, D, dg * 32, nullptr, wmo + (size_t)l * D * D, dg * 32, scr, kb, F.lane); }
    }
    { bf16* const xa = (bf16*)(F.ws + WS_XA); float* const ssp = (float*)(F.ws + WS_SSP); const float* x = F.in[IN_X];
      for (int m = gw; m < M; m += NGW) {
          const GAS f32x4* xr = (const GAS f32x4*)(x + (size_t)m * D) + F.lane; f32x4 v[4]; float s = 0.f;
#pragma unroll
          for (int j = 0; j < 4; ++j) { v[j] = xr[64 * j]; s += (v[j].x * v[j].x + v[j].y * v[j].y) + (v[j].z * v[j].z + v[j].w * v[j].w); }
          s = wave_sum(s);
          GAS unsigned long long* o8 = (GAS unsigned long long*)(xa + (size_t)m * D) + F.lane;
#pragma unroll
          for (int j = 0; j < 4; ++j) o8[64 * j] = (unsigned long long)cvtpk(v[j].x, v[j].y) | ((unsigned long long)cvtpk(v[j].z, v[j].w) << 32);
          if (F.lane < 16) ssp[(size_t)m * 16 + F.lane] = (F.lane == 0) ? s : 0.f;
      } }
    { const int gt = F.bid * NTHREADS + F.tid, NT = F.G * NTHREADS;
      bf16* const wgt = (bf16*)(F.ws + WS_WGT); float* const wst = (float*)(F.ws + WS_WST); float* const sp = (float*)(F.ws + WS_SP);
      for (int e = gt; e < 2 * LRU_HEADS * 64 * 64; e += NT) {
          const int i = e & 63, j = (e >> 6) & 63, h = (e >> 12) & 15, g = e >> 16;
          const float w = F.in[g ? IN_REC_GXW : IN_REC_GAW][(h * 64 + i) * 64 + j];
          wgt[e] = (bf16)(cvtpk(w, 0.f) & 0xffffu); }
      for (int e = gt; e < SG_HEADS * CHUNK * CHUNK; e += NT) {
          const int p = e & 127, q = (e >> 7) & 127, h = e >> 14;
          wst[e] = (q <= p) ? F.in[IN_SG_WS][(h * CHUNK + p) * CHUNK + q] : 0.f; }
      for (int e = gt; e < D; e += NT) sp[e] = log1pf(expf(-F.in[IN_REC_LAMBDA][e]));
    }
}

constexpr int SC_T = 64, SC_LD = 260, SC_NC = SEQ / SC_T;
static_assert(2 * SC_T * SC_LD * 4 <= SCR_BYTES, "scan LDS");
__device__ __forceinline__ void scan_phase(Frame& F, int pass) {
    LAS float* const XF = (LAS float*)F.lds; LAS float* const AA = XF + SC_T * SC_LD;
    const int tid = F.tid, lane = F.lane, w = F.wave;
    const bf16* const YR = (const bf16*)(F.ws + WS_YR); bf16* const YH = (bf16*)(F.ws + WS_YH);
    float* const Aagg = (float*)(F.ws + WS_AAGG); float* const Bagg = (float*)(F.ws + WS_BAGG);
    const bf16* const wgt = (const bf16*)(F.ws + WS_WGT); const float* const spv = (const float*)(F.ws + WS_SP);
    const float* const convw = F.in[IN_REC_CONVW]; const float* const convb = F.in[IN_REC_CONVB]; const float* const gab = F.in[IN_REC_GAB]; const float* const gxb = F.in[IN_REC_GXB];
    for (int it = F.bid; it < BATCH * SC_NC * 4; it += F.G) {
        const int hg = it & 3, c = (it >> 2) & (SC_NC - 1), b = it >> 9;
        const int t0 = c * SC_T, chb = hg * 256; const size_t rowb = (size_t)b * SEQ;
        { const int cp = tid & 127, tq = tid >> 7, ch = chb + 2 * cp, tl0 = tq * 16;
          const f32x2v w0 = *(const f32x2v*)(convw + 0 * D + ch), w1 = *(const f32x2v*)(convw + 1 * D + ch), w2 = *(const f32x2v*)(convw + 2 * D + ch), w3 = *(const f32x2v*)(convw + 3 * D + ch), cb = *(const f32x2v*)(convb + ch);
          unsigned raw[19];
#pragma unroll
          for (int i = 0; i < 19; ++i) { const int s = t0 + tl0 - 3 + i; const int sc = s < 0 ? 0 : s; const unsigned v = *(const unsigned*)(YR + (rowb + sc) * NMIX + D + ch); raw[i] = (s >= 0) ? v : 0u; }
#pragma unroll
          for (int i = 0; i < 16; ++i) {
              const f32x2v r3 = {bflo(raw[i]), bfhi(raw[i])}, r2 = {bflo(raw[i + 1]), bfhi(raw[i + 1])}, r1 = {bflo(raw[i + 2]), bfhi(raw[i + 2])}, r0 = {bflo(raw[i + 3]), bfhi(raw[i + 3])};
              const f32x2v o = cb + w0 * r3 + w1 * r2 + w2 * r1 + w3 * r0;
              *(LAS f32x2v*)(XF + (tl0 + i) * SC_LD + 2 * cp) = o; } }
        __syncthreads();
        { const int hd = w >> 1, th = w & 1, r32 = lane & 31, hi = lane >> 5, head = hg * 4 + hd;
          f32x16 acc[2][2];
#pragma unroll
          for (int g = 0; g < 2; ++g)
#pragma unroll
              for (int nb = 0; nb < 2; ++nb)
#pragma unroll
                  for (int r = 0; r < 16; ++r) acc[g][nb][r] = 0.f;
#pragma unroll
          for (int ks = 0; ks < 4; ++ks) {
              const LAS float* ap = XF + (th * 32 + r32) * SC_LD + hd * 64 + 16 * ks + 8 * hi;
              const f32x4 a0 = *(const LAS f32x4*)ap, a1 = *(const LAS f32x4*)(ap + 4);
              u32x4 aw; aw.x = cvtpk(a0[0], a0[1]); aw.y = cvtpk(a0[2], a0[3]); aw.z = cvtpk(a1[0], a1[1]); aw.w = cvtpk(a1[2], a1[3]);
              const bf16x8 af = __builtin_bit_cast(bf16x8, aw);
#pragma unroll
              for (int g = 0; g < 2; ++g)
#pragma unroll
                  for (int nb = 0; nb < 2; ++nb) {
                      const bf16x8 bfr = *(const bf16x8*)(wgt + ((size_t)((g * LRU_HEADS + head) * 64 + nb * 32 + r32)) * 64 + 16 * ks + 8 * hi);
                      acc[g][nb] = __builtin_amdgcn_mfma_f32_32x32x16_bf16(af, bfr, acc[g][nb], 0, 0, 0); } }
#pragma unroll
          for (int nb = 0; nb < 2; ++nb) {
              const int chl = hd * 64 + nb * 32 + r32, chg = chb + chl;
              const float ba = gab[chg], bx = gxb[chg], spc = spv[chg];
#pragma unroll
              for (int r = 0; r < 16; ++r) {
                  const int tok = th * 32 + (r & 3) + 8 * (r >> 2) + 4 * hi;
                  const float ga = sigmoid_f(acc[0][nb][r] + ba), gx = sigmoid_f(acc[1][nb][r] + bx);
                  const float la = -8.0f * ga * spc, a = __builtin_amdgcn_exp2f(1.4426950408889634f * la), z = 2.0f * la;
                  const float em_poly = z * (1.0f + z * (0.5f + z * (0.16666667f + z * (0.041666668f + z * (0.0083333338f + z * 0.0013888889f)))));
                  const float em = (z > -0.3f) ? em_poly : (a * a - 1.0f);
                  const float mult = __builtin_amdgcn_sqrtf(-em);
                  LAS float* px = XF + tok * SC_LD + chl;
                  const float xf = *px;
                  AA[tok * SC_LD + chl] = a; *px = xf * gx * mult; } } }
        __syncthreads();
        if (tid < 256) {
            const size_t ai = ((size_t)(b * SC_NC + c)) * D + chb + tid;
            if (pass == 1) {
                float P = 1.f, h = 0.f;
#pragma unroll 8
                for (int t = 0; t < SC_T; ++t) { const float a = AA[t * SC_LD + tid], bb = XF[t * SC_LD + tid]; h = a * h + bb; P *= a; }
                Aagg[ai] = P; Bagg[ai] = h;
            } else {
                float h = 0.f;
                const float* pa = Aagg + (size_t)b * SC_NC * D + chb + tid; const float* pb = Bagg + (size_t)b * SC_NC * D + chb + tid;
#pragma unroll 8
                for (int cc = 0; cc < c; ++cc) h = pa[(size_t)cc * D] * h + pb[(size_t)cc * D];
#pragma unroll 8
                for (int t = 0; t < SC_T; ++t) { const float a = AA[t * SC_LD + tid], bb = XF[t * SC_LD + tid]; h = a * h + bb; XF[t * SC_LD + tid] = h; }
            }
        }
        __syncthreads();
        if (pass == 2) {
#pragma unroll
            for (int p = 0; p < 4; ++p) {
                const int tl = p * 16 + (tid >> 5), j = tid & 31; const size_t row = rowb + t0 + tl;
                const u32x4 yv = *(const u32x4*)(YR + row * NMIX + chb + 8 * j);
                const f32x4 h0 = *(const LAS f32x4*)(XF + tl * SC_LD + 8 * j), h1 = *(const LAS f32x4*)(XF + tl * SC_LD + 8 * j + 4);
                u32x4 o; o.x = cvtpk(bflo(yv.x) * h0[0], bfhi(yv.x) * h0[1]); o.y = cvtpk(bflo(yv.y) * h0[2], bfhi(yv.y) * h0[3]);
                o.z = cvtpk(bflo(yv.z) * h1[0], bfhi(yv.z) * h1[1]); o.w = cvtpk(bflo(yv.w) * h1[2], bfhi(yv.w) * h1[3]);
                *(u32x4*)(YH + row * D + chb + 8 * j) = o; }
            __syncthreads();
        }
    }
}

constexpr int SP_LD = 128;
__device__ __forceinline__ void spatial_phase(Frame& F) {
    LAS float* const VN = (LAS float*)F.lds;
    const int tid = F.tid, lane = F.lane, w = F.wave, r32 = lane & 31, hi = lane >> 5;
    const bf16* const UV = (const bf16*)(F.ws + WS_YR); bf16* const US = (bf16*)(F.ws + WS_YH);
    const float* const vssp = (const float*)(F.ws + WS_VSSP); const float* const wst = (const float*)(F.ws + WS_WST);
    const float* const vng = F.in[IN_SG_VNORM]; const float* const bs = F.in[IN_SG_BS];
    for (int it = F.bid; it < BATCH * (SEQ / CHUNK) * SG_HEADS; it += F.G) {
        const int h = it & 7, n = (it >> 3) & 63, b = it >> 9; const size_t row0 = (size_t)b * SEQ + (size_t)n * CHUNK;
#pragma unroll
        for (int p = 0; p < 4; ++p) {
            const int q = p * 32 + (tid >> 4), j = tid & 15; const size_t row = row0 + q;
            const f32x4 s0 = *(const f32x4*)(vssp + row * 16), s1 = *(const f32x4*)(vssp + row * 16 + 4), s2 = *(const f32x4*)(vssp + row * 16 + 8), s3 = *(const f32x4*)(vssp + row * 16 + 12);
            const float ss = ((s0[0] + s0[1]) + (s0[2] + s0[3])) + ((s1[0] + s1[1]) + (s1[2] + s1[3])) + ((s2[0] + s2[1]) + (s2[2] + s2[3])) + ((s3[0] + s3[1]) + (s3[2] + s3[3]));
            const float rv = __builtin_amdgcn_rsqf(ss * (1.0f / 1024.0f) + NORM_EPS);
            const u32x4 vv = *(const u32x4*)(UV + row * NMIX + D + h * SG_HD + 8 * j);
            const f32x4 g0 = *(const f32x4*)(vng + h * SG_HD + 8 * j), g1 = *(const f32x4*)(vng + h * SG_HD + 8 * j + 4);
            f32x4 o0, o1;
            o0[0] = bflo(vv.x) * rv * g0[0]; o0[1] = bfhi(vv.x) * rv * g0[1]; o0[2] = bflo(vv.y) * rv * g0[2]; o0[3] = bfhi(vv.y) * rv * g0[3];
            o1[0] = bflo(vv.z) * rv * g1[0]; o1[1] = bfhi(vv.z) * rv * g1[1]; o1[2] = bflo(vv.w) * rv * g1[2]; o1[3] = bfhi(vv.w) * rv * g1[3];
            *(LAS f32x4*)(VN + q * SP_LD + 8 * j) = o0; *(LAS f32x4*)(VN + q * SP_LD + 8 * j + 4) = o1; }
        __syncthreads();
        const int rb = w >> 1, chh = w & 1;
        f32x16 acc0, acc1;
#pragma unroll
        for (int r = 0; r < 16; ++r) { acc0[r] = 0.f; acc1[r] = 0.f; }
        { const float* wt = wst + (size_t)h * CHUNK * CHUNK + rb * 32 + r32; const LAS float* vb = VN + chh * 64 + r32;
          const int nks = 16 * (rb + 1);
#pragma unroll 4
          for (int ks = 0; ks < nks; ++ks) { const int q = 2 * ks + hi;
              const float a = wt[q * CHUNK]; const float b0 = vb[q * SP_LD], b1 = vb[q * SP_LD + 32];
              acc0 = __builtin_amdgcn_mfma_f32_32x32x2f32(a, b0, acc0, 0, 0, 0); acc1 = __builtin_amdgcn_mfma_f32_32x32x2f32(a, b1, acc1, 0, 0, 0); } }
        __syncthreads();
#pragma unroll
        for (int r = 0; r < 16; ++r) { const int p = rb * 32 + (r & 3) + 8 * (r >> 2) + 4 * hi; const float bias = bs[h * CHUNK + p];
            VN[p * SP_LD + chh * 64 + r32] = acc0[r] + bias; VN[p * SP_LD + chh * 64 + 32 + r32] = acc1[r] + bias; }
        __syncthreads();
#pragma unroll
        for (int p = 0; p < 4; ++p) {
            const int q = p * 32 + (tid >> 4), j = tid & 15; const size_t row = row0 + q;
            const u32x4 uv = *(const u32x4*)(UV + row * NMIX + h * SG_HD + 8 * j);
            const f32x4 s0 = *(const LAS f32x4*)(VN + q * SP_LD + 8 * j), s1 = *(const LAS f32x4*)(VN + q * SP_LD + 8 * j + 4);
            u32x4 o; o.x = cvtpk(bflo(uv.x) * s0[0], bfhi(uv.x) * s0[1]); o.y = cvtpk(bflo(uv.y) * s0[2], bfhi(uv.y) * s0[3]);
            o.z = cvtpk(bflo(uv.z) * s1[0], bfhi(uv.z) * s1[1]); o.w = cvtpk(bflo(uv.w) * s1[2], bfhi(uv.w) * s1[3]);
            *(u32x4*)(US + row * D + h * SG_HD + 8 * j) = o; }
        __syncthreads();
    }
}

__device__ __forceinline__ void final_phase(Frame& F) {
    const int gw = F.bid * NWAVES + F.wave, NGW = F.G * NWAVES; const float* const g = F.in[IN_FINAL_NORM];
    const bf16* const xa = (const bf16*)(F.ws + WS_XA);
    f32x4 gv[4];
#pragma unroll
    for (int j = 0; j < 4; ++j) gv[j] = *((const f32x4*)g + 2 * F.lane + (j & 1) + 128 * (j >> 1));
    for (int m = gw; m < M; m += NGW) {
        const u32x4 r0 = *((const u32x4*)(xa + (size_t)m * D) + F.lane), r1 = *((const u32x4*)(xa + (size_t)m * D) + 64 + F.lane);
        f32x4 v[4];
        v[0] = (f32x4){bflo(r0.x), bfhi(r0.x), bflo(r0.y), bfhi(r0.y)}; v[1] = (f32x4){bflo(r0.z), bfhi(r0.z), bflo(r0.w), bfhi(r0.w)};
        v[2] = (f32x4){bflo(r1.x), bfhi(r1.x), bflo(r1.y), bfhi(r1.y)}; v[3] = (f32x4){bflo(r1.z), bfhi(r1.z), bflo(r1.w), bfhi(r1.w)};
        float s = 0.f;
#pragma unroll
        for (int j = 0; j < 4; ++j) s += (v[j].x * v[j].x + v[j].y * v[j].y) + (v[j].z * v[j].z + v[j].w * v[j].w);
        const float rinv = __builtin_amdgcn_rsqf(wave_sum(s) * (1.0f / D) + NORM_EPS);
        GAS f32x4* o = (GAS f32x4*)(F.out + (size_t)m * D);
#pragma unroll
        for (int j = 0; j < 4; ++j) o[2 * F.lane + (j & 1) + 128 * (j >> 1)] = v[j] * rinv * gv[j];
    }
}

__global__ void __launch_bounds__(NTHREADS, 2) mk_fwd(Args args) {
    extern __shared__ __attribute__((aligned(16))) unsigned char lds[];
    Frame F;
    F.lds = (LAS unsigned char*)lds; F.tid = threadIdx.x; F.lane = F.tid & 63; F.wave = __builtin_amdgcn_readfirstlane(F.tid >> 6);
    F.G = gridDim.x; F.bid = blockIdx.x; F.in = args.in; F.out = args.out; F.ws = args.ws; F.ctl = (gu32*)(args.ws + WS_CTL);
    for (int u = F.tid; u < (LDS_BYTES - LDSCTL_OFF) / 4; u += NTHREADS) ((LAS unsigned*)(F.lds + LDSCTL_OFF))[u] = 0u;
    __syncthreads();
    XcdBarrier bar; bar.bar = (unsigned*)(F.ctl + CW_BAR); bar.x = 0; bar.st = nullptr;
    if (N_LAUNCHES == 1) bar = xcd_barrier_post((unsigned*)(F.ctl + CW_BAR), (volatile LAS unsigned*)(F.lds + LDSCTL_OFF) + 8);
    const int lo = args.ph_lo, hi = args.ph_hi;
#ifndef PROBE_DUP
#define PROBE_DUP (-1)
#endif
#define IN(k) (lo <= (k) && (k) < hi)
#define SEAM(k) do { if (IN((k) + 1)) xcd_barrier(bar); } while (0)
#define WSP(T, off) ((T*)(args.ws + (off)))
#define FFN_IN(k, l, f) if (IN(k)) { \
        pg8::Gemm g{WSP(const bf16, WS_XA), WSP(const bf16, WS_WFI) + (size_t)(2 * (l) + (f)) * NFF2 * D, M, NFF2, D}; pg8::StaticOrder S; S.init(M, NFF2, F.G, F.bid); \
        pg8::EpiSwiGLU E{WSP(bf16, WS_HID), FF, WSP(const float, WS_SSP), NORM_EPS}; \
        pg8::gemm_phase<pg8::EpiSwiGLU, pg8::StaticOrder, true, true>(F.lds, g, S, E); SEAM(k); }
#define FFN_OUT(k, l, f, basep) if (IN(k)) { \
        pg8::Gemm g{WSP(const bf16, WS_HID), WSP(const bf16, WS_WFO) + (size_t)(2 * (l) + (f)) * D * FF, M, D, FF}; pg8::StaticOrder S; S.init(M, D, F.G, F.bid); \
        pg8::EpiRes E{WSP(bf16, WS_XA), WSP(float, WS_SSP), 0.5f}; \
        pg8::gemm_phase<pg8::EpiRes, pg8::StaticOrder, true, true>(F.lds, g, S, E); SEAM(k); }
#define MIX_IN(k, l) if (IN(k)) { \
        pg8::Gemm g{WSP(const bf16, WS_XA), WSP(const bf16, WS_WMI) + (size_t)(l) * NMIX * D, M, NMIX, D}; pg8::StaticOrder S; S.init(M, NMIX, F.G, F.bid); \
        pg8::EpiMixIn E{WSP(bf16, WS_YR), WSP(const float, WS_SSP), NORM_EPS, (l), WSP(float, WS_VSSP)}; \
        pg8::gemm_phase<pg8::EpiMixIn, pg8::StaticOrder, true, true>(F.lds, g, S, E); SEAM(k); }
#define MIX_OUT(k, l) if (IN(k)) { \
        pg8::Gemm g{WSP(const bf16, WS_YH), WSP(const bf16, WS_WMO) + (size_t)(l) * D * D, M, D, D}; pg8::StaticOrder S; S.init(M, D, F.G, F.bid); \
        pg8::EpiRes E{WSP(bf16, WS_XA), WSP(float, WS_SSP), 1.0f}; \
        pg8::gemm_phase<pg8::EpiRes, pg8::StaticOrder, true, true>(F.lds, g, S, E); SEAM(k); }

    if (IN(0)) { p0_prologue(F); SEAM(0); }
#if PROBE_DUP == 0
    if (IN(0)) { p0_prologue(F); SEAM(0); }
#endif
    FFN_IN(1, 0, 0)
#if PROBE_DUP == 1
    FFN_IN(1, 0, 0)
#endif
    FFN_OUT(2, 0, 0, 0)
#if PROBE_DUP == 2
    FFN_OUT(2, 0, 0, 0)
#endif
    MIX_IN(3, 0)
#if PROBE_DUP == 3
    MIX_IN(3, 0)
#endif
    if (IN(4)) { scan_phase(F, 1); SEAM(4); }
#if PROBE_DUP == 4
    if (IN(4)) { scan_phase(F, 1); SEAM(4); }
#endif
    if (IN(5)) { scan_phase(F, 2); SEAM(5); }
#if PROBE_DUP == 5
    if (IN(5)) { scan_phase(F, 2); SEAM(5); }
#endif
    MIX_OUT(6, 0)
    FFN_IN(7, 0, 1)
    FFN_OUT(8, 0, 1, 0)
    FFN_IN(9, 1, 0)
    FFN_OUT(10, 1, 0, 0)
    MIX_IN(11, 1)
    if (IN(12)) { spatial_phase(F); SEAM(12); }
#if PROBE_DUP == 12
    if (IN(12)) { spatial_phase(F); SEAM(12); }
#endif
    MIX_OUT(13, 1)
    FFN_IN(14, 1, 1)
    FFN_OUT(15, 1, 1, 0)
    if (IN(16)) final_phase(F);
#undef IN
#undef SEAM
#undef WSP
#undef FFN_IN
#undef FFN_OUT
#undef MIX_IN
#undef MIX_OUT
}

extern "C" void kernel_launch(void* const* d_in, const int* in_sizes, int n_in, void* d_out, int out_size, void* d_ws, size_t ws_size, hipStream_t stream) {
    static int grid = 0;
    if (grid == 0) {
        if (n_in != 23 || in_sizes[0] != M * D || out_size != M * D || ws_size < WS_END) { fprintf(stderr, "kernel_launch: unexpected shapes (n_in %d, in0 %d, out %d, ws %zu); nothing launched\n", n_in, n_in > 0 ? in_sizes[0] : -1, out_size, ws_size); grid = -1; return; }
        int dev = 0, cus = 0, per_cu = 0;
        if (hipGetDevice(&dev) != hipSuccess || hipDeviceGetAttribute(&cus, hipDeviceAttributeMultiprocessorCount, dev) != hipSuccess) { fprintf(stderr, "kernel_launch: device query failed\n"); grid = -1; return; }
        if (hipFuncSetAttribute((const void*)mk_fwd, hipFuncAttributeMaxDynamicSharedMemorySize, LDS_BYTES) != hipSuccess) { fprintf(stderr, "kernel_launch: hipFuncSetAttribute failed\n"); grid = -1; return; }
        if (hipOccupancyMaxActiveBlocksPerMultiprocessor(&per_cu, (const void*)mk_fwd, NTHREADS, LDS_BYTES) != hipSuccess || per_cu < 1) { fprintf(stderr, "kernel_launch: occupancy query reports %d blocks per CU; nothing launched\n", per_cu); (void)hipGetLastError(); grid = -1; return; }
        grid = cus;
    }
    if (grid < 0) return;
    if (hipMemsetAsync((char*)d_ws + WS_CTL, 0, CTL_ZERO_BYTES, stream) != hipSuccess) { fprintf(stderr, "kernel_launch: memset failed\n"); return; }
    Args a{};
    for (int i = 0; i < 23; ++i) a.in[i] = (const float*)d_in[i];
    a.out = (float*)d_out; a.ws = (unsigned char*)d_ws;
    for (int li = 0; li < N_LAUNCHES; ++li) {
        a.ph_lo = (N_LAUNCHES == 1) ? 0 : li; a.ph_hi = (N_LAUNCHES == 1) ? N_PHASES : li + 1; a.li = li;
        hipLaunchKernelGGL(mk_fwd, dim3(grid), dim3(NTHREADS), LDS_BYTES, stream, a);
        const hipError_t le = hipPeekAtLastError();
        if (le != hipSuccess) { fprintf(stderr, "kernel_launch: launch %d failed: %s\n", li, hipGetErrorName(le)); break; }
    }
}
```
